# Optimizing an MI355X kernel written in HIP

```python
import jax
import jax.numpy as jnp
from jax import lax
import numpy as np

D_MODEL = 1024
BATCH = 2
SEQ = 8192
DEPTH = 2
DEC_BATCH = 128
DEC_SEQ = 4
PAST_LEN = 16384
PAGE_SIZE = 128

N_MIXERS = 2
N_A = (DEPTH + 1) // 2
N_B = DEPTH // 2
D_PLE = 256
EPS = 1e-6
D_RNN = D_MODEL
N_LRU_BLOCKS = 8
LRU_BLOCK = D_RNN // N_LRU_BLOCKS
CONV_W = 4
LRU_C = 8.0
HEAD_DIM = 64
N_HEADS = D_MODEL // HEAD_DIM
N_KV = N_HEADS // 4
GROUP = N_HEADS // N_KV
Q_W = N_HEADS * HEAD_DIM
KV_W = N_KV * HEAD_DIM
D_ATT = Q_W
WINDOW = 128
BLOCK = 128
ALIBI_MAX = 8.0
NEG_INF = -1e30

kernel_name = 'hybrid_rglru_swa_sink_decoder_step'


def _rmsnorm(x, g):
    xf = x.astype(jnp.float32)
    xf = xf * lax.rsqrt(jnp.mean(xf * xf, axis=-1, keepdims=True) + EPS)
    return (xf * g.astype(jnp.float32)).astype(x.dtype)


def _alibi_slopes():
    return jnp.exp2(-ALIBI_MAX * jnp.arange(1, N_HEADS + 1, dtype=jnp.float32) / N_HEADS)


def _causal_conv(x, prev, w, b):
    T = x.shape[1]
    xp = jnp.concatenate([prev.astype(x.dtype), x], axis=1)
    y = b
    for k in range(CONV_W):
        y = y + xp[:, k:k + T] * w[k]
    return y, xp[:, -(CONV_W - 1):]


def _block_diag(x, w, b):
    xb = x.reshape(x.shape[:-1] + (N_LRU_BLOCKS, LRU_BLOCK))
    return jnp.einsum('...nc,ncd->...nd', xb, w).reshape(x.shape) + b


def _rg_lru(xc, h0, wr, br, wi, bi, lam):
    xf = xc.astype(jnp.float32)
    r = jax.nn.sigmoid(_block_diag(xf, wr.astype(jnp.float32), br.astype(jnp.float32)))
    i = jax.nn.sigmoid(_block_diag(xf, wi.astype(jnp.float32), bi.astype(jnp.float32)))
    log_a = -LRU_C * r * jax.nn.softplus(-lam.astype(jnp.float32))
    a = jnp.exp(log_a)
    b = jnp.sqrt(-jnp.expm1(2.0 * log_a)) * (i * xf)
    b = b.at[:, 0].add(a[:, 0] * h0.astype(jnp.float32))

    def combine(left, right):
        return left[0] * right[0], right[0] * left[1] + right[1]

    _, h = lax.associative_scan(combine, (a, b), axis=1)
    return h, h[:, -1]


def _mixer_a(u, h0, conv_prev, w_in, cw, cb, wr, br, wi, bi, lam, w_out):
    xg = u @ w_in
    xb, gate = xg[..., :D_RNN], xg[..., D_RNN:]
    xc, conv_new = _causal_conv(xb, conv_prev, cw, cb)
    h, h_last = _rg_lru(xc, h0, wr, br, wi, bi, lam)
    y = (h.astype(u.dtype) * jax.nn.silu(gate)) @ w_out
    return y, h_last, conv_new


def _sink_attention(q, k, v, dist, valid, sinks, slopes):
    s = jnp.einsum('...qkgd,...skd->...kgqs', q.astype(jnp.float32), k.astype(jnp.float32)) * (HEAD_DIM ** -0.5)
    s = s - slopes[:, :, None, None] * dist.astype(jnp.float32)
    s = jnp.where(valid, s, NEG_INF)
    sink_col = jnp.broadcast_to(sinks.astype(jnp.float32)[:, :, None, None], s.shape[:-1] + (1,))
    p = jax.nn.softmax(jnp.concatenate([s, sink_col], axis=-1), axis=-1)[..., :-1]
    return jnp.einsum('...kgqs,...skd->...qkgd', p, v.astype(jnp.float32))


def _mixer_b(u, kbuf, vbuf, w_in, sinks, w_out):
    Bn, T, _ = u.shape
    proj = u @ w_in
    q = proj[..., :Q_W].reshape(Bn, T, N_KV, GROUP, HEAD_DIM)
    k = proj[..., Q_W:Q_W + KV_W].reshape(Bn, T, N_KV, HEAD_DIM)
    v = proj[..., Q_W + KV_W:Q_W + 2 * KV_W].reshape(Bn, T, N_KV, HEAD_DIM)
    gate = proj[..., Q_W + 2 * KV_W:]
    sink = sinks.reshape(N_KV, GROUP)
    slopes = _alibi_slopes().reshape(N_KV, GROUP)
    if kbuf is None:
        nb = T // BLOCK
        qb = q.reshape(Bn, nb, BLOCK, N_KV, GROUP, HEAD_DIM)
        kb = k.reshape(Bn, nb, BLOCK, N_KV, HEAD_DIM)
        vb = v.reshape(Bn, nb, BLOCK, N_KV, HEAD_DIM)

        def band(xb):
            prev = jnp.concatenate([jnp.zeros_like(xb[:, :1]), xb[:, :-1]], axis=1)
            return jnp.concatenate([prev, xb], axis=2)

        qi = jnp.arange(BLOCK)[:, None]
        si = jnp.arange(2 * BLOCK)[None, :]
        dist = BLOCK + qi - si
        blk = jnp.arange(nb)[:, None, None]
        valid = (dist >= 0) & (dist < WINDOW) & ((blk - 1) * BLOCK + si >= 0)
        o = _sink_attention(qb, band(kb), band(vb), dist, valid[:, None, None], sink, slopes)
        new_k, new_v = k[:, -WINDOW:], v[:, -WINDOW:]
    else:
        W = kbuf.shape[1]
        k_all = jnp.concatenate([kbuf.astype(k.dtype), k], axis=1)
        v_all = jnp.concatenate([vbuf.astype(v.dtype), v], axis=1)
        qi = jnp.arange(T)[:, None]
        si = jnp.arange(W + T)[None, :]
        dist = W + qi - si
        valid = (dist >= 0) & (dist < WINDOW)
        o = _sink_attention(q, k_all, v_all, dist, valid, sink, slopes)
        new_k, new_v = k_all[:, -WINDOW:], v_all[:, -WINDOW:]
    o = o.reshape(Bn, T, Q_W).astype(u.dtype)
    return (o * jax.nn.silu(gate)) @ w_out, new_k, new_v


def _trunk(x, p, lru_h, conv_st, kc, vc, weights):
    (norm_g, final_norm_g, ple_norm_g, w_ple_gate, w_ple_proj, w_in_a, conv_w_a, conv_b_a,
     w_rgate, b_rgate, w_igate, b_igate, lru_lambda, w_out_a, w_in_b, sinks, w_out_b) = weights
    Bn = x.shape[0]
    new_h, new_conv, new_k, new_v = [], [], [], []
    h = x
    for i in range(DEPTH):
        j = i // N_MIXERS
        u = _rmsnorm(h, norm_g[i])
        if i % N_MIXERS == 0:
            h0 = jnp.zeros((Bn, D_RNN), jnp.float32) if lru_h is None else lru_h[j]
            cprev = jnp.zeros((Bn, CONV_W - 1, D_RNN), x.dtype) if conv_st is None else conv_st[j]
            y, hl, cn = _mixer_a(u, h0, cprev, w_in_a[j], conv_w_a[j], conv_b_a[j], w_rgate[j], b_rgate[j],
                                 w_igate[j], b_igate[j], lru_lambda[j], w_out_a[j])
            new_h.append(hl)
            new_conv.append(cn)
        else:
            y, nk, nv = _mixer_b(u, None if kc is None else kc[j], None if vc is None else vc[j],
                                 w_in_b[j], sinks[j], w_out_b[j])
            new_k.append(nk)
            new_v.append(nv)
        h = h + y
        gate = jax.nn.sigmoid((_rmsnorm(h, ple_norm_g[i]) @ w_ple_gate[i]).astype(jnp.float32)).astype(h.dtype)
        h = h + gate * (p[i] @ w_ple_proj[i])
    return (_rmsnorm(h, final_norm_g), jnp.stack(new_h), jnp.stack(new_conv), jnp.stack(new_k), jnp.stack(new_v))


def setup_inputs(seed: int = 0) -> dict:
    key = jax.random.key(seed)
    ks = jax.random.split(key, 26)

    def nrm(k, shape, scale):
        return jax.random.normal(k, shape, jnp.float32) * scale

    a0 = jax.random.uniform(ks[20], (N_A, D_RNN), jnp.float32, 0.9, 0.999)
    s0 = a0 ** (1.0 / LRU_C)
    return {
        'x_prompt': nrm(ks[0], (BATCH, SEQ, D_MODEL), 1.0),
        'x_sample': nrm(ks[1], (DEC_BATCH, DEC_SEQ, D_MODEL), 1.0),
        'p_prompt': nrm(ks[2], (DEPTH, BATCH, SEQ, D_PLE), 1.0),
        'p_sample': nrm(ks[3], (DEPTH, DEC_BATCH, DEC_SEQ, D_PLE), 1.0),
        'state_lru_h': nrm(ks[4], (N_A, DEC_BATCH, D_RNN), 0.5),
        'state_conv': nrm(ks[5], (N_A, DEC_BATCH, CONV_W - 1, D_RNN), 1.0),
        'cache_k': nrm(ks[6], (N_B, DEC_BATCH, WINDOW, N_KV, HEAD_DIM), 1.0),
        'cache_v': nrm(ks[7], (N_B, DEC_BATCH, WINDOW, N_KV, HEAD_DIM), 1.0),
        'norm_g': 1.0 + nrm(ks[8], (DEPTH, D_MODEL), 0.02),
        'final_norm_g': 1.0 + nrm(ks[9], (D_MODEL,), 0.02),
        'ple_norm_g': 1.0 + nrm(ks[10], (DEPTH, D_MODEL), 0.02),
        'w_ple_gate': nrm(ks[11], (DEPTH, D_MODEL, D_MODEL), D_MODEL ** -0.5),
        'w_ple_proj': nrm(ks[12], (DEPTH, D_PLE, D_MODEL), D_PLE ** -0.5),
        'w_in_a': nrm(ks[13], (N_A, D_MODEL, 2 * D_RNN), D_MODEL ** -0.5),
        'conv_w_a': nrm(ks[14], (N_A, CONV_W, D_RNN), CONV_W ** -0.5),
        'conv_b_a': nrm(ks[15], (N_A, D_RNN), 0.01),
        'w_rgate': nrm(ks[16], (N_A, N_LRU_BLOCKS, LRU_BLOCK, LRU_BLOCK), LRU_BLOCK ** -0.5),
        'b_rgate': nrm(ks[17], (N_A, D_RNN), 0.01),
        'w_igate': nrm(ks[18], (N_A, N_LRU_BLOCKS, LRU_BLOCK, LRU_BLOCK), LRU_BLOCK ** -0.5),
        'b_igate': nrm(ks[19], (N_A, D_RNN), 0.01),
        'lru_lambda': jnp.log(s0) - jnp.log1p(-s0),
        'w_out_a': nrm(ks[21], (N_A, D_RNN, D_MODEL), D_RNN ** -0.5),
        'w_in_b': nrm(ks[22], (N_B, D_MODEL, Q_W + 2 * KV_W + D_ATT), D_MODEL ** -0.5),
        'sinks': nrm(ks[23], (N_B, N_HEADS), 0.5),
        'w_out_b': nrm(ks[24], (N_B, D_ATT, D_MODEL), D_ATT ** -0.5),
    }


def reference(x_prompt, x_sample, p_prompt, p_sample, state_lru_h, state_conv, cache_k, cache_v,
              norm_g, final_norm_g, ple_norm_g, w_ple_gate, w_ple_proj, w_in_a, conv_w_a, conv_b_a,
              w_rgate, b_rgate, w_igate, b_igate, lru_lambda, w_out_a, w_in_b, sinks, w_out_b):
    weights = (norm_g, final_norm_g, ple_norm_g, w_ple_gate, w_ple_proj, w_in_a, conv_w_a, conv_b_a,
               w_rgate, b_rgate, w_igate, b_igate, lru_lambda, w_out_a, w_in_b, sinks, w_out_b)
    y_prompt, h_p, conv_p, k_p, v_p = _trunk(x_prompt, p_prompt, None, None, None, None, weights)
    y_sample, h_s, conv_s, k_s, v_s = _trunk(x_sample, p_sample, state_lru_h, state_conv, cache_k, cache_v, weights)
    return (y_prompt, y_sample, h_p, conv_p, k_p, v_p, h_s, conv_s, k_s, v_s)
```

```cpp
#include <hip/hip_runtime.h>
#include <hip/hip_cooperative_groups.h>
#include <cstdio>
#include <cstdint>
namespace cg = cooperative_groups;
namespace pg8 {
#define PG8_LAS __attribute__((address_space(3)))
typedef unsigned short bf16_t;
typedef short bf16x8 __attribute__((ext_vector_type(8)));
typedef float f32x4 __attribute__((ext_vector_type(4)));
typedef unsigned u32x4 __attribute__((ext_vector_type(4)));
constexpr int BM = 256, BK = 64, HALF = 128, HTB = HALF * BK * 2  , STAGE_BYTES = 8 * HTB, NXCD = 8, WGM = 8;

__host__ __device__ __forceinline__ int lds_byte(int r, int c) { const int st = (r >> 4) * 2 + (c >> 5), rr = r & 15, cc = c & 31, ob = rr * 64 + cc * 2; return st * 1024 + (ob ^ (((ob >> 9) & 1) << 5)); }
__host__ __device__ __forceinline__ void stage_rc(int b, int& R, int& C) { const int st = b / 1024, sb = b % 1024, swz = sb ^ (((sb >> 9) & 1) << 5); R = (st >> 1) * 16 + swz / 64; C = (st & 1) * 32 + (swz % 64) / 2; }
__host__ __device__ __forceinline__ int perm32(int rho) { const int n = rho >> 4, i = rho & 15; return 8 * (i >> 2) + 4 * n + (i & 3); }

struct Unit { int pm, pn; };
struct Gemm { const bf16_t* A; const bf16_t* Bt; int M, N, K; };

struct StaticOrder {
    int nM, nN, nwg, G, c;
    __host__ __device__ void init(int M, int N, int G_, int c_) { nM = M / BM; nN = N / BM; nwg = nM * nN; G = G_; c = c_; }
    __host__ __device__ bool next(int i, Unit& u) const {
        const long L = (long)i * G + c; if (L >= nwg) return false;
        int wgid = (int)L; { const int q = nwg / NXCD, r = nwg % NXCD, xcd = wgid % NXCD, off = wgid / NXCD; wgid = (xcd < r ? xcd * (q + 1) : r * (q + 1) + (xcd - r) * q) + off; }
        const int nig = WGM * nN, gid = wgid / nig, fm = gid * WGM, gsz = (nM - fm) < WGM ? (nM - fm) : WGM;
        u.pm = fm + ((wgid % nig) % gsz); u.pn = (wgid % nig) / gsz; return true;
    }
    __device__ __forceinline__ void a_ready(const Unit&) const {}
    __device__ __forceinline__ void done(const Unit&) const {}
};

__device__ __forceinline__ unsigned cvt_pk_bf16(float lo, float hi) { unsigned r; asm volatile("v_cvt_pk_bf16_f32 %0, %1, %2" : "=v"(r) : "v"(lo), "v"(hi)); return r; }
template <class Epi, class Sched, bool ALIGN_EPI = false, bool SP2 = false>
__device__ __forceinline__ void gemm_phase(PG8_LAS unsigned char* lds, const Gemm g, const Sched& S, const Epi& E) {
    int tid_ = threadIdx.x; asm volatile("" : "+v"(tid_));
    const int tid = tid_, wid = __builtin_amdgcn_readfirstlane(tid >> 6), lane = tid & 63, wr = wid >> 2, wc = wid & 3, fr = lane & 15, fq = lane >> 4;
    const int K = g.K, nt = K / BK;
    unsigned voffA[2], voffB[2];
#pragma unroll
    for (int i = 0; i < 2; ++i) { int R, C; stage_rc(tid * 16 + i * 8192, R, C); const int Rb = Epi::PERM ? ((R & ~31) + perm32(R & 31)) : R;
        voffA[i] = (unsigned)(R * K + C) * 2u; voffB[i] = (unsigned)(Rb * K + C) * 2u; }
    const size_t kstep = (size_t)(BK * 2);
    const size_t hstep = (size_t)HALF * K * 2;
    const size_t tstep = 2 * hstep;
    const unsigned ldsw = (unsigned)wid * 1024u;
    const int aoff = lds_byte(wr * 64 + fr, fq * 8), boff = lds_byte(wc * 32 + fr, fq * 8);
#define PG8_SA(b, h) (((b) * 2 + (h)) * HTB)
#define PG8_SB(b, h) ((4 + (b) * 2 + (h)) * HTB)
#define PG8_STAGE(bufoff, gbase, voff) do { _Pragma("unroll") for (int _i = 0; _i < 2; ++_i) \
        __builtin_amdgcn_global_load_lds((const unsigned*)((const char*)(gbase) + (voff)[_i]), (PG8_LAS unsigned*)(lds + (bufoff) + ldsw + _i * 8192), 16, 0, 0); } while (0)
#define PG8_LDA(dst, b, h) do { _Pragma("unroll") for (int m = 0; m < 4; ++m) _Pragma("unroll") for (int k = 0; k < 2; ++k) dst[m][k] = *(const PG8_LAS bf16x8*)(lds + PG8_SA(b, h) + aoff + m * 2048 + k * 1024); } while (0)
#define PG8_LDB(dst, b, h) do { _Pragma("unroll") for (int n = 0; n < 2; ++n) _Pragma("unroll") for (int k = 0; k < 2; ++k) dst[n][k] = *(const PG8_LAS bf16x8*)(lds + PG8_SB(b, h) + boff + n * 2048 + k * 1024); } while (0)
#define PG8_MMA(ai, bj, At, Bt) do { __builtin_amdgcn_s_setprio(1); _Pragma("unroll") for (int m = 0; m < 4; ++m) _Pragma("unroll") for (int n = 0; n < 2; ++n) _Pragma("unroll") for (int k = 0; k < 2; ++k) \
        acc[ai][bj][m][n] = __builtin_amdgcn_mfma_f32_16x16x32_bf16(Bt[n][k], At[m][k], acc[ai][bj][m][n], 0, 0, 0); __builtin_amdgcn_s_setprio(0); } while (0)
#define PG8_WAIT_V(n) asm volatile("s_waitcnt vmcnt(" #n ")" ::: "memory")
#define PG8_WAIT_L(n) asm volatile("s_waitcnt lgkmcnt(" #n ")" ::: "memory")
#define PG8_BAR __builtin_amdgcn_s_barrier()
#define PG8_SCHED __builtin_amdgcn_sched_barrier(0)
    Unit cur, nxt; int ui = 0;
    if (!S.next(0, cur)) return;
    f32x4 acc[2][2][4][2];
#pragma unroll
    for (int a = 0; a < 2; ++a)
#pragma unroll
        for (int b = 0; b < 2; ++b)
#pragma unroll
            for (int m = 0; m < 4; ++m)
#pragma unroll
                for (int n = 0; n < 2; ++n) acc[a][b][m][n] = (f32x4){0.f, 0.f, 0.f, 0.f};
    bf16x8 At[4][2], B0[2][2], B1[2][2];
    const char* cA = (const char*)g.A + (size_t)cur.pm * tstep; const char* cB = (const char*)g.Bt + (size_t)cur.pn * tstep;
    S.a_ready(cur);
    if constexpr (SP2) {
        PG8_STAGE(PG8_SB(0, 0), cB, voffB); PG8_STAGE(PG8_SB(0, 1), cB + hstep, voffB); PG8_STAGE(PG8_SA(0, 0), cA, voffA); PG8_STAGE(PG8_SA(0, 1), cA + hstep, voffA);
        if (wr == 1) PG8_BAR;
        PG8_WAIT_V(2); PG8_BAR;
        PG8_STAGE(PG8_SB(1, 0), cB + kstep, voffB); PG8_STAGE(PG8_SA(1, 0), cA + kstep, voffA); PG8_STAGE(PG8_SB(1, 1), cB + hstep + kstep, voffB);
        PG8_WAIT_V(6); PG8_BAR;
    } else {
        PG8_STAGE(PG8_SB(0, 0), cB, voffB); PG8_STAGE(PG8_SA(0, 0), cA, voffA); PG8_STAGE(PG8_SB(0, 1), cB + hstep, voffB); PG8_STAGE(PG8_SA(0, 1), cA + hstep, voffA);
        if (wr == 1) PG8_BAR;
        PG8_WAIT_V(4); PG8_BAR;
        PG8_STAGE(PG8_SB(1, 0), cB + kstep, voffB); PG8_STAGE(PG8_SA(1, 0), cA + kstep, voffA); PG8_STAGE(PG8_SB(1, 1), cB + hstep + kstep, voffB);
        PG8_WAIT_V(6); PG8_BAR;
    }
    for (;;) {
        const bool has_next = S.next(ui + 1, nxt);
        const char* nA = has_next ? (const char*)g.A + (size_t)nxt.pm * tstep : cA; const char* nB = has_next ? (const char*)g.Bt + (size_t)nxt.pn * tstep : cB;
        for (int t = 0; t < nt; t += 2) {
            const bool last = (t == nt - 2);
            const char* a1 = cA + (size_t)(t + 1) * kstep;
            const char* a2 = last ? nA : cA + (size_t)(t + 2) * kstep; const char* b2 = last ? nB : cB + (size_t)(t + 2) * kstep;
            const char* a3 = a2 + kstep; const char* b3 = b2 + kstep;
            if (last && has_next) S.a_ready(nxt);
            if constexpr (SP2) {
            PG8_LDB(B0, 0, 0); PG8_LDB(B1, 0, 1); PG8_SCHED; PG8_LDA(At, 0, 0); PG8_STAGE(PG8_SA(1, 1), a1 + hstep, voffA);
            PG8_WAIT_V(8); PG8_WAIT_L(0); PG8_BAR; PG8_MMA(0, 0, At, B0); PG8_MMA(0, 1, At, B1); PG8_BAR; PG8_SCHED;
            PG8_LDA(At, 0, 1); PG8_STAGE(PG8_SB(0, 0), b2, voffB); PG8_STAGE(PG8_SB(0, 1), b2 + hstep, voffB); PG8_STAGE(PG8_SA(0, 0), a2, voffA);
            PG8_WAIT_V(8); PG8_WAIT_L(0); PG8_BAR; PG8_MMA(1, 0, At, B0); PG8_MMA(1, 1, At, B1); PG8_BAR; PG8_SCHED;
            PG8_LDB(B0, 1, 0); PG8_LDB(B1, 1, 1); PG8_SCHED; PG8_LDA(At, 1, 0); PG8_STAGE(PG8_SA(0, 1), a2 + hstep, voffA);
            PG8_WAIT_V(8); PG8_WAIT_L(0); PG8_BAR; PG8_MMA(0, 0, At, B0); PG8_MMA(0, 1, At, B1); PG8_BAR; PG8_SCHED;
            PG8_LDA(At, 1, 1); PG8_STAGE(PG8_SB(1, 0), b3, voffB); PG8_STAGE(PG8_SB(1, 1), b3 + hstep, voffB); PG8_STAGE(PG8_SA(1, 0), a3, voffA);
            PG8_WAIT_V(8); PG8_WAIT_L(0); PG8_BAR; PG8_MMA(1, 0, At, B0); PG8_MMA(1, 1, At, B1); PG8_BAR; PG8_SCHED;
            } else {
            PG8_LDB(B0, 0, 0); PG8_SCHED; PG8_LDA(At, 0, 0); PG8_STAGE(PG8_SA(1, 1), a1 + hstep, voffA);
            PG8_WAIT_L(8); PG8_BAR; PG8_WAIT_L(0); PG8_MMA(0, 0, At, B0); PG8_BAR; PG8_SCHED;
            PG8_LDB(B1, 0, 1); PG8_STAGE(PG8_SB(0, 0), b2, voffB);
            PG8_BAR; PG8_WAIT_L(0); PG8_MMA(0, 1, At, B1); PG8_BAR;
            PG8_LDA(At, 0, 1); PG8_STAGE(PG8_SA(0, 0), a2, voffA);
            PG8_BAR; PG8_WAIT_L(0); PG8_MMA(1, 0, At, B0); PG8_BAR; PG8_SCHED;
            PG8_STAGE(PG8_SB(0, 1), b2 + hstep, voffB);
            PG8_WAIT_V(6); PG8_BAR; PG8_MMA(1, 1, At, B1); PG8_BAR;
            PG8_LDB(B0, 1, 0); PG8_SCHED; PG8_LDA(At, 1, 0); PG8_STAGE(PG8_SA(0, 1), a2 + hstep, voffA);
            PG8_WAIT_L(8); PG8_BAR; PG8_WAIT_L(0); PG8_MMA(0, 0, At, B0); PG8_BAR; PG8_SCHED;
            PG8_LDB(B1, 1, 1); PG8_STAGE(PG8_SB(1, 0), b3, voffB);
            PG8_BAR; PG8_WAIT_L(0); PG8_MMA(0, 1, At, B1); PG8_BAR;
            PG8_LDA(At, 1, 1); PG8_STAGE(PG8_SA(1, 0), a3, voffA);
            PG8_BAR; PG8_WAIT_L(0); PG8_MMA(1, 0, At, B0); PG8_BAR; PG8_SCHED;
            PG8_STAGE(PG8_SB(1, 1), b3 + hstep, voffB);
            PG8_WAIT_V(6); PG8_BAR; PG8_MMA(1, 1, At, B1); PG8_BAR;
            }
        }
        if constexpr (ALIGN_EPI) { if (wr == 0) PG8_BAR; }
        if constexpr (!Epi::AFTER_DRAIN) { E(acc, cur, wr, wc, fr, fq); S.done(cur); }
        if (!has_next) break;
#pragma unroll
        for (int a = 0; a < 2; ++a)
#pragma unroll
            for (int b = 0; b < 2; ++b)
#pragma unroll
                for (int m = 0; m < 4; ++m)
#pragma unroll
                    for (int n = 0; n < 2; ++n) acc[a][b][m][n] = (f32x4){0.f, 0.f, 0.f, 0.f};
        cur = nxt; cA = nA; cB = nB; ++ui;
        if constexpr (ALIGN_EPI) { if (wr == 1) PG8_BAR; }
    }
    PG8_WAIT_V(0);
    if constexpr (!ALIGN_EPI) { if (wr == 0) PG8_BAR; }
    PG8_BAR;
    if constexpr (Epi::AFTER_DRAIN) { E.fused(acc, cur, wr, wc, fr, fq, lds, wid, lane); S.done(cur); }
#undef PG8_SA
#undef PG8_SB
#undef PG8_STAGE
#undef PG8_LDA
#undef PG8_LDB
#undef PG8_MMA
#undef PG8_WAIT_V
#undef PG8_WAIT_L
#undef PG8_BAR
#undef PG8_SCHED
}
}

typedef unsigned short bf16;
typedef short bf16x8 __attribute__((ext_vector_type(8)));
typedef float f32x4 __attribute__((ext_vector_type(4)));
typedef float f32x16 __attribute__((ext_vector_type(16)));
typedef unsigned u32x4 __attribute__((ext_vector_type(4)));
typedef unsigned u32x2 __attribute__((ext_vector_type(2)));

constexpr int DM = 1024, SEQ = 8192, MP = 16384, MS = 512, MT = MP + MS;
constexpr float EPSN = 1e-6f;
constexpr float LOG2E = 1.4426950408889634f;
constexpr size_t O_Y = 0, O_HP = (size_t)MT * DM, O_CONVP = O_HP + 2048, O_KP = O_CONVP + 6144, O_VP = O_KP + 65536, O_HS = O_VP + 65536,
                 O_CONVS = O_HS + 131072, O_KS = O_CONVS + 393216, O_VS = O_KS + 4194304, O_END = O_VS + 4194304;
constexpr size_t MiB = 1u << 20;
constexpr size_t WS_SS = 0;
constexpr size_t WS_SUM = 1 * MiB;
constexpr size_t WS_W1 = 4 * MiB, WS_WOA = 8 * MiB, WS_WPG0 = 10 * MiB, WS_WPP0 = 12 * MiB, WS_WPP1 = 12 * MiB + 512 * 1024, WS_WINB = 13 * MiB,
                 WS_WOB = 18 * MiB, WS_WPG1 = 20 * MiB, WS_WR = 22 * MiB, WS_WI = 22 * MiB + 256 * 1024;
constexpr size_t WS_PB = 24 * MiB;
constexpr size_t WS_SA = 41 * MiB, WS_SB = 74 * MiB, WS_SC = 107 * MiB, WS_SD = 140 * MiB, WS_KV = 173 * MiB;
constexpr size_t WS_SE = 190 * MiB;
constexpr size_t WS_END = 223 * MiB;
constexpr int LDS_BYTES = 147456;

__device__ __forceinline__ unsigned pk2(float lo, float hi) {
    typedef float f32x2_t __attribute__((ext_vector_type(2))); typedef __bf16 bf16x2_t __attribute__((ext_vector_type(2)));
    f32x2_t v = {lo, hi}; bf16x2_t b = __builtin_convertvector(v, bf16x2_t); return __builtin_bit_cast(unsigned, b);
}
__device__ __forceinline__ float bf2f(unsigned short b) { return __uint_as_float((unsigned)b << 16); }
__device__ __forceinline__ float bflo(unsigned w) { return __uint_as_float(w << 16); }
__device__ __forceinline__ float bfhi(unsigned w) { return __uint_as_float(w & 0xffff0000u); }
__device__ __forceinline__ float sigmoidf_(float v) { return __builtin_amdgcn_rcpf(1.0f + __expf(-v)); }
__device__ __forceinline__ float siluf_(float v) { return v * sigmoidf_(v); }
__device__ __forceinline__ int crow(int r, int hi) { return (r & 3) + 8 * (r >> 2) + 4 * hi; }
#define LDS_WAIT() asm volatile("s_waitcnt lgkmcnt(0)" ::: "memory")

namespace pg8 {
struct SubsetOrder {
    int nN, nwg, Gs, c;
    __device__ bool next(int i, Unit& u) const { if (c < 0) return false; const int L = i * Gs + c; if (L >= nwg) return false; u.pm = L / nN; u.pn = L % nN; return true; }
    __device__ __forceinline__ void a_ready(const Unit&) const {}
    __device__ __forceinline__ void done(const Unit&) const {}
};
struct EpiInA {
    static constexpr bool PERM = true, AFTER_DRAIN = false;
    const float* ss; bf16_t* XBR; bf16_t* GS; float* conv_p; float* conv_s;
    __device__ __forceinline__ void operator()(const f32x4 (&acc)[2][2][4][2], const Unit& u, int wr, int wc, int fr, int fq) const {
        const int colt = u.pn * BM; const bool is_gate = colt >= 1024;
        bf16_t* base = is_gate ? GS : XBR; const int cb = (is_gate ? colt - 1024 : colt) + wc * 32 + 8 * fq;
        float rsv[2][4];
#pragma unroll
        for (int ai = 0; ai < 2; ++ai)
#pragma unroll
            for (int m = 0; m < 4; ++m) rsv[ai][m] = ss[u.pm * BM + ai * HALF + wr * 64 + m * 16 + fr];
#pragma unroll
        for (int ai = 0; ai < 2; ++ai)
#pragma unroll
            for (int m = 0; m < 4; ++m) {
                const int row = u.pm * BM + ai * HALF + wr * 64 + m * 16 + fr;
                const float rs = rsqrtf(rsv[ai][m] * (1.0f / 1024.0f) + EPSN);
                float* cdst = nullptr;
                if (!is_gate) {
                    if (row < MP) { const int t = row & (SEQ - 1); if (t >= SEQ - 3) cdst = conv_p + (size_t)((row >> 13) * 3 + (t - (SEQ - 3))) * 1024; }
                    else { const int s = row - MP, t = s & 3; if (t >= 1) cdst = conv_s + (size_t)((s >> 2) * 3 + (t - 1)) * 1024; }
                }
#pragma unroll
                for (int bj = 0; bj < 2; ++bj) {
                    f32x4 v0 = acc[ai][bj][m][0] * rs, v1 = acc[ai][bj][m][1] * rs; const int col = cb + bj * HALF;
                    if (cdst) { *(f32x4*)(cdst + col) = v0; *(f32x4*)(cdst + col + 4) = v1; }
                    if (is_gate) {
#pragma unroll
                        for (int e = 0; e < 4; ++e) { v0[e] = siluf_(v0[e]); v1[e] = siluf_(v1[e]); }
                    }
                    u32x4 w; w.x = pk2(v0[0], v0[1]); w.y = pk2(v0[2], v0[3]); w.z = pk2(v1[0], v1[1]); w.w = pk2(v1[2], v1[3]);
                    *(u32x4*)(base + (size_t)row * 1024 + col) = w;
                }
            }
    }
};
struct EpiInB {
    static constexpr bool PERM = true, AFTER_DRAIN = false;
    const float* ss; bf16_t* QB; bf16_t* KB; bf16_t* VB; bf16_t* GS; float* kp; float* vp; float* ks; float* vs;
    __device__ __forceinline__ void operator()(const f32x4 (&acc)[2][2][4][2], const Unit& u, int wr, int wc, int fr, int fq) const {
        const int pn = u.pn; const int kind = pn < 4 ? 0 : (pn == 4 ? 1 : (pn == 5 ? 2 : 3));
        bf16_t* base; int ld, cb;
        if (kind == 0) { base = QB; ld = 1024; cb = pn * BM; } else if (kind == 1) { base = KB; ld = 256; cb = 0; } else if (kind == 2) { base = VB; ld = 256; cb = 0; } else { base = GS; ld = 1024; cb = (pn - 6) * BM; }
        cb += wc * 32 + 8 * fq;
        float* op = kind == 1 ? kp : vp; float* os = kind == 1 ? ks : vs;
        float rsv[2][4];
#pragma unroll
        for (int ai = 0; ai < 2; ++ai)
#pragma unroll
            for (int m = 0; m < 4; ++m) rsv[ai][m] = ss[u.pm * BM + ai * HALF + wr * 64 + m * 16 + fr];
#pragma unroll
        for (int ai = 0; ai < 2; ++ai)
#pragma unroll
            for (int m = 0; m < 4; ++m) {
                const int row = u.pm * BM + ai * HALF + wr * 64 + m * 16 + fr;
                const float rs = rsqrtf(rsv[ai][m] * (1.0f / 1024.0f) + EPSN);
                float* cdst = nullptr;
                if (kind == 1 || kind == 2) {
                    if (row < MP) { const int t = row & (SEQ - 1); if (t >= SEQ - 128) cdst = op + (size_t)((row >> 13) * 128 + (t - (SEQ - 128))) * 256; }
                    else { const int s = row - MP; cdst = os + (size_t)((s >> 2) * 128 + 124 + (s & 3)) * 256; }
                }
#pragma unroll
                for (int bj = 0; bj < 2; ++bj) {
                    f32x4 v0 = acc[ai][bj][m][0] * rs, v1 = acc[ai][bj][m][1] * rs; const int col = cb + bj * HALF;
                    if (cdst) { *(f32x4*)(cdst + col) = v0; *(f32x4*)(cdst + col + 4) = v1; }
                    if (kind == 3) {
#pragma unroll
                        for (int e = 0; e < 4; ++e) { v0[e] = siluf_(v0[e]); v1[e] = siluf_(v1[e]); }
                    }
                    u32x4 w; w.x = pk2(v0[0], v0[1]); w.y = pk2(v0[2], v0[3]); w.z = pk2(v1[0], v1[1]); w.w = pk2(v1[2], v1[3]);
                    *(u32x4*)(base + (size_t)row * ld + col) = w;
                }
            }
    }
};
#define EP_LD16(base, eoff) (*(const u32x4*)((const char*)(base) + (size_t)(unsigned)((eoff) * 2u)))
#define EP_ST16(base, eoff, v) (*(u32x4*)((char*)(base) + (size_t)(unsigned)((eoff) * 2u)) = (v))
struct EpiRes {
    static constexpr bool PERM = true, AFTER_DRAIN = false;
    const bf16_t* res; bf16_t* HB; float* ssout;
    __device__ __forceinline__ void operator()(const f32x4 (&acc)[2][2][4][2], const Unit& u, int wr, int wc, int fr, int fq) const {
        const int col0 = u.pn * BM + wc * 32 + 8 * fq; const int rowb = u.pm * BM + wr * 64 + fr;
        const unsigned ob = (unsigned)rowb * 1024u + (unsigned)col0;
        u32x4 buf[4][2];
#define EPI_LD(i, s) do { const unsigned o_ = ob + (unsigned)((((i) >> 2) * HALF + ((i) & 3) * 16) * 1024); buf[s][0] = EP_LD16(res, o_); buf[s][1] = EP_LD16(res, o_ + HALF); } while (0)
        EPI_LD(0, 0); EPI_LD(1, 1); EPI_LD(2, 2);
#pragma unroll
        for (int i = 0; i < 8; ++i) {
            if (i < 5) EPI_LD(i + 3, (i + 3) & 3);
            const int ai = i >> 2, m = i & 3; const int row = rowb + ai * HALF + m * 16; const unsigned orow = ob + (unsigned)((ai * HALF + m * 16) * 1024);
            float sq = 0.f;
#pragma unroll
            for (int bj = 0; bj < 2; ++bj) { const u32x4 rw = buf[i & 3][bj];
                const f32x4 h0 = (f32x4){bflo(rw.x), bfhi(rw.x), bflo(rw.y), bfhi(rw.y)} + acc[ai][bj][m][0], h1 = (f32x4){bflo(rw.z), bfhi(rw.z), bflo(rw.w), bfhi(rw.w)} + acc[ai][bj][m][1];
                u32x4 w; w.x = pk2(h0[0], h0[1]); w.y = pk2(h0[2], h0[3]); w.z = pk2(h1[0], h1[1]); w.w = pk2(h1[2], h1[3]); EP_ST16(HB, orow + bj * HALF, w);
                sq += ((h0[0] * h0[0] + h0[1] * h0[1]) + (h0[2] * h0[2] + h0[3] * h0[3])) + ((h1[0] * h1[0] + h1[1] * h1[1]) + (h1[2] * h1[2] + h1[3] * h1[3])); }
            sq += __shfl_xor(sq, 16); sq += __shfl_xor(sq, 32);
            if (fq == 0) atomicAdd(ssout + row, sq);
        }
#undef EPI_LD
    }
};
struct EpiPP {
    static constexpr bool PERM = true, AFTER_DRAIN = false;
    bf16_t* PP;
    __device__ __forceinline__ void operator()(const f32x4 (&acc)[2][2][4][2], const Unit& u, int wr, int wc, int fr, int fq) const {
        const unsigned ob = (unsigned)(u.pm * BM + wr * 64 + fr) * 1024u + (unsigned)(u.pn * BM + wc * 32 + 8 * fq);
#pragma unroll
        for (int ai = 0; ai < 2; ++ai)
#pragma unroll
            for (int m = 0; m < 4; ++m) {
#pragma unroll
                for (int bj = 0; bj < 2; ++bj) { const f32x4 h0 = acc[ai][bj][m][0], h1 = acc[ai][bj][m][1];
                    u32x4 w; w.x = pk2(h0[0], h0[1]); w.y = pk2(h0[2], h0[3]); w.z = pk2(h1[0], h1[1]); w.w = pk2(h1[2], h1[3]); EP_ST16(PP, ob + (unsigned)((ai * HALF + m * 16) * 1024 + bj * HALF), w); }
            }
    }
};
struct EpiPle {
    static constexpr bool PERM = true, AFTER_DRAIN = false;
    const float* ssin; const bf16_t* Hin; const bf16_t* PP; bf16_t* HB; float* ssout;
    __device__ __forceinline__ void operator()(const f32x4 (&acc)[2][2][4][2], const Unit& u, int wr, int wc, int fr, int fq) const {
        const int col0 = u.pn * BM + wc * 32 + 8 * fq; const int rowb = u.pm * BM + wr * 64 + fr;
        const unsigned ob = (unsigned)rowb * 1024u + (unsigned)col0;
        u32x4 hb[2][2], pb[2][2]; float rsb[2];
#define EPI_LD(i, s) do { const unsigned o_ = ob + (unsigned)((((i) >> 2) * HALF + ((i) & 3) * 16) * 1024); hb[s][0] = EP_LD16(Hin, o_); hb[s][1] = EP_LD16(Hin, o_ + HALF); \
            pb[s][0] = EP_LD16(PP, o_); pb[s][1] = EP_LD16(PP, o_ + HALF); rsb[s] = ssin[rowb + ((i) >> 2) * HALF + ((i) & 3) * 16]; } while (0)
        EPI_LD(0, 0);
#pragma unroll
        for (int i = 0; i < 8; ++i) {
            if (i < 7) EPI_LD(i + 1, (i + 1) & 1);
            const int ai = i >> 2, m = i & 3; const int row = rowb + ai * HALF + m * 16; const unsigned orow = ob + (unsigned)((ai * HALF + m * 16) * 1024);
            const float rs = rsqrtf(rsb[i & 1] * (1.0f / 1024.0f) + EPSN);
            float sq = 0.f;
#pragma unroll
            for (int bj = 0; bj < 2; ++bj) { const u32x4 hw = hb[i & 1][bj], pw = pb[i & 1][bj];
                const f32x4 a0 = acc[ai][bj][m][0] * rs, a1 = acc[ai][bj][m][1] * rs;
                f32x4 h0 = {bflo(hw.x), bfhi(hw.x), bflo(hw.y), bfhi(hw.y)}, h1 = {bflo(hw.z), bfhi(hw.z), bflo(hw.w), bfhi(hw.w)};
                h0[0] += sigmoidf_(a0[0]) * bflo(pw.x); h0[1] += sigmoidf_(a0[1]) * bfhi(pw.x); h0[2] += sigmoidf_(a0[2]) * bflo(pw.y); h0[3] += sigmoidf_(a0[3]) * bfhi(pw.y);
                h1[0] += sigmoidf_(a1[0]) * bflo(pw.z); h1[1] += sigmoidf_(a1[1]) * bfhi(pw.z); h1[2] += sigmoidf_(a1[2]) * bflo(pw.w); h1[3] += sigmoidf_(a1[3]) * bfhi(pw.w);
                u32x4 w; w.x = pk2(h0[0], h0[1]); w.y = pk2(h0[2], h0[3]); w.z = pk2(h1[0], h1[1]); w.w = pk2(h1[2], h1[3]); EP_ST16(HB, orow + bj * HALF, w);
                sq += ((h0[0] * h0[0] + h0[1] * h0[1]) + (h0[2] * h0[2] + h0[3] * h0[3])) + ((h1[0] * h1[0] + h1[1] * h1[1]) + (h1[2] * h1[2] + h1[3] * h1[3])); }
            sq += __shfl_xor(sq, 16); sq += __shfl_xor(sq, 32);
            if (fq == 0) atomicAdd(ssout + row, sq);
        }
#undef EPI_LD
    }
};
}

struct Args { const float* in[25]; float* out; unsigned char* ws; int ph_lo, ph_hi; };
enum { I_XP = 0, I_XS, I_PP, I_PS, I_LRUH, I_CONVST, I_CK, I_CV, I_NORMG, I_FNORMG, I_PLENG, I_WPG, I_WPP, I_WINA, I_CONVW, I_CONVB, I_WR, I_BR, I_WI, I_BI, I_LAM, I_WOA, I_WINB, I_SINKS, I_WOB };

__device__ __forceinline__ float wave_sum(float v) {
#pragma unroll
    for (int o = 1; o < 64; o <<= 1) v += __shfl_xor(v, o);
    return v;
}

__device__ __forceinline__ void p0_transpose_item(const float* W, int K, int N, bf16* WT, const float* g, float* scr, int item, int lane) {
    const int nblk = N / 32, kb = item / nblk, nb = item % nblk, k0 = 64 * kb, n0 = 32 * nb;
    float wv[32];
#pragma unroll
    for (int i = 0; i < 32; ++i) wv[i] = W[(size_t)(k0 + 2 * i + (lane >> 5)) * N + n0 + (lane & 31)];
#pragma unroll
    for (int i = 0; i < 32; ++i) { const int kk = 2 * i + (lane >> 5); float v = wv[i]; if (g) v *= g[k0 + kk]; scr[kk * 33 + (lane & 31)] = v; }
    LDS_WAIT();
    const int c = lane & 7;
#pragma unroll
    for (int j = 0; j < 4; ++j) { const int n = (lane >> 3) + 8 * j; const float* s = scr + (8 * c) * 33 + n;
        u32x4 o; o.x = pk2(s[0 * 33], s[1 * 33]); o.y = pk2(s[2 * 33], s[3 * 33]); o.z = pk2(s[4 * 33], s[5 * 33]); o.w = pk2(s[6 * 33], s[7 * 33]);
        *(u32x4*)(WT + (size_t)(n0 + n) * K + k0 + 8 * c) = o; }
    LDS_WAIT();
}

__device__ __forceinline__ void p0_prologue(const Args& a, unsigned char* lds, int tid, int lane, int wave, int bx, int G) {
    unsigned char* ws = a.ws;
    float* scr = (float*)(lds + wave * 16384);
    const int gw = bx * 8 + wave, NGW = G * 8;
    constexpr int I0 = 1024, I1 = 512, I2 = 512, I3 = 128, I4 = 512, I5 = 128, I6 = 1280, I7 = 512, I8 = 64, I9 = 64;
    constexpr int NITEMS = I0 + I1 + I2 + I3 + I4 + I5 + I6 + I7 + I8 + I9;
    for (int it = gw; it < NITEMS; it += NGW) {
        int r = it;
        if (r < I0) { p0_transpose_item(a.in[I_WINA], 1024, 2048, (bf16*)(ws + WS_W1), a.in[I_NORMG], scr, r, lane); continue; } r -= I0;
        if (r < I1) { p0_transpose_item(a.in[I_WOA], 1024, 1024, (bf16*)(ws + WS_WOA), nullptr, scr, r, lane); continue; } r -= I1;
        if (r < I2) { p0_transpose_item(a.in[I_WPG], 1024, 1024, (bf16*)(ws + WS_WPG0), a.in[I_PLENG], scr, r, lane); continue; } r -= I2;
        if (r < I3) { p0_transpose_item(a.in[I_WPP], 256, 1024, (bf16*)(ws + WS_WPP0), nullptr, scr, r, lane); continue; } r -= I3;
        if (r < I4) { p0_transpose_item(a.in[I_WPG] + 1024 * 1024, 1024, 1024, (bf16*)(ws + WS_WPG1), a.in[I_PLENG] + 1024, scr, r, lane); continue; } r -= I4;
        if (r < I5) { p0_transpose_item(a.in[I_WPP] + 256 * 1024, 256, 1024, (bf16*)(ws + WS_WPP1), nullptr, scr, r, lane); continue; } r -= I5;
        if (r < I6) { p0_transpose_item(a.in[I_WINB], 1024, 2560, (bf16*)(ws + WS_WINB), a.in[I_NORMG] + 1024, scr, r, lane); continue; } r -= I6;
        if (r < I7) { p0_transpose_item(a.in[I_WOB], 1024, 1024, (bf16*)(ws + WS_WOB), nullptr, scr, r, lane); continue; } r -= I7;
        if (r < I8) { const int blk = r >> 3; p0_transpose_item(a.in[I_WR] + blk * 16384, 128, 128, (bf16*)(ws + WS_WR) + blk * 16384, nullptr, scr, r & 7, lane); continue; } r -= I8;
        { const int blk = r >> 3; p0_transpose_item(a.in[I_WI] + blk * 16384, 128, 128, (bf16*)(ws + WS_WI) + blk * 16384, nullptr, scr, r & 7, lane); }
    }
    float* SS = (float*)(ws + WS_SS); bf16* XA = (bf16*)(ws + WS_SA);
    for (int m0 = 2 * gw; m0 < MT; m0 += 2 * NGW) {
        f32x4 v[2][4]; float sv[2];
#pragma unroll
        for (int rr = 0; rr < 2; ++rr) { const int m = m0 + rr; const float* xrow = m < MP ? a.in[I_XP] + (size_t)m * 1024 : a.in[I_XS] + (size_t)(m - MP) * 1024; const f32x4* xr = (const f32x4*)xrow + lane;
#pragma unroll
            for (int j = 0; j < 4; ++j) v[rr][j] = xr[64 * j]; }
#pragma unroll
        for (int rr = 0; rr < 2; ++rr) { float s = 0.f;
#pragma unroll
            for (int j = 0; j < 4; ++j) s += (v[rr][j].x * v[rr][j].x + v[rr][j].y * v[rr][j].y) + (v[rr][j].z * v[rr][j].z + v[rr][j].w * v[rr][j].w);
            sv[rr] = wave_sum(s); }
#pragma unroll
        for (int rr = 0; rr < 2; ++rr) { const int m = m0 + rr; u32x2* o8 = (u32x2*)(XA + (size_t)m * 1024) + lane;
#pragma unroll
            for (int j = 0; j < 4; ++j) { u32x2 w; w.x = pk2(v[rr][j].x, v[rr][j].y); w.y = pk2(v[rr][j].z, v[rr][j].w); o8[64 * j] = w; }
            if (lane == 0) { SS[m] = sv[rr]; SS[MT + m] = 0.f; SS[2 * MT + m] = 0.f; SS[3 * MT + m] = 0.f; SS[4 * MT + m] = 0.f; } }
    }
    bf16* PB = (bf16*)(ws + WS_PB);
    const int gt = bx * 512 + tid, NT = G * 512;
    for (int e0 = gt; e0 < 2 * MT * 32; e0 += 2 * NT) {
        f32x4 v0[2], v1[2]; bool ok[2]; size_t dst[2];
#pragma unroll
        for (int k = 0; k < 2; ++k) { const int e = e0 + k * NT; ok[k] = e < 2 * MT * 32; const int ee = ok[k] ? e : e0;
            const int l = ee / (MT * 32), rem = ee % (MT * 32), row = rem >> 5, q = rem & 31;
            const float* src = row < MP ? a.in[I_PP] + ((size_t)l * MP + row) * 256 + q * 8 : a.in[I_PS] + ((size_t)l * MS + (row - MP)) * 256 + q * 8;
            v0[k] = *(const f32x4*)src; v1[k] = *(const f32x4*)(src + 4); dst[k] = ((size_t)l * MT + row) * 256 + q * 8; }
#pragma unroll
        for (int k = 0; k < 2; ++k) if (ok[k]) { u32x4 w; w.x = pk2(v0[k].x, v0[k].y); w.y = pk2(v0[k].z, v0[k].w); w.z = pk2(v1[k].x, v1[k].y); w.w = pk2(v1[k].z, v1[k].w); *(u32x4*)(PB + dst[k]) = w; }
    }
}

constexpr int L_AB = 0, L_XC = 65536, L_XCB = 98304, L_SEG = 115712, XCBS = 136;
struct LruP { const bf16* XBR; const bf16* GS; bf16* HG; const bf16* WRt; const bf16* WIt; const float* convw; const float* convb; const float* br; const float* bi; const float* lam;
              const float* lruh; const float* convst; float* SUM; float* hp; float* hs; };

struct LruConsts { float w0, w1, w2, w3, cbv, brv, biv, sp8; };
__device__ __forceinline__ void lru_gates_r(const bf16* XCB, const float* XC, float (&avr)[16], float (&bvr)[16], const bf16x8 (&wrf)[8], const bf16x8 (&wif)[8], const float brv, const float biv, const float sp8, int rb, int cbk, int jl, int hi) {
    f32x16 aR = {}, aI = {};
#pragma unroll
    for (int ks = 0; ks < 8; ++ks) { const bf16x8 af = *(const bf16x8*)(XCB + (32 * rb + jl) * XCBS + 16 * ks + 8 * hi);
        aR = __builtin_amdgcn_mfma_f32_32x32x16_bf16(af, wrf[ks], aR, 0, 0, 0); aI = __builtin_amdgcn_mfma_f32_32x32x16_bf16(af, wif[ks], aI, 0, 0, 0); }
    typedef float f32x2 __attribute__((ext_vector_type(2)));
#pragma unroll
    for (int r = 0; r < 16; r += 2) {
        const int i = 32 * rb + crow(r, hi), j = 32 * cbk + jl; const f32x2 xc = {XC[i * 128 + j], XC[(i + 1) * 128 + j]};
        const f32x2 zr = ((f32x2){aR[r], aR[r + 1]} + brv) * -LOG2E, zi = ((f32x2){aI[r], aI[r + 1]} + biv) * -LOG2E;
        f32x2 ea, eb; ea.x = __builtin_amdgcn_exp2f(fminf(zr.x, 60.f)); ea.y = __builtin_amdgcn_exp2f(fminf(zr.y, 60.f)); eb.x = __builtin_amdgcn_exp2f(fminf(zi.x, 60.f)); eb.y = __builtin_amdgcn_exp2f(fminf(zi.y, 60.f));
        ea = ea + 1.0f; eb = eb + 1.0f; const f32x2 den = ea * eb; f32x2 inv; inv.x = __builtin_amdgcn_rcpf(den.x); inv.y = __builtin_amdgcn_rcpf(den.y);
        const f32x2 rr = eb * inv, ii = ea * inv, la = rr * -sp8, le = la * LOG2E; f32x2 av; av.x = __builtin_amdgcn_exp2f(le.x); av.y = __builtin_amdgcn_exp2f(le.y);
        const f32x2 x2 = la * 2.0f; const f32x2 ser = -x2 * (x2 * (x2 * (x2 * 0.041666668f + 0.16666667f) + 0.5f) + 1.0f), big = 1.0f - av * av;
        f32x2 om; om.x = x2.x > -0.05f ? ser.x : big.x; om.y = x2.y > -0.05f ? ser.y : big.y;
        f32x2 sq; sq.x = __builtin_amdgcn_sqrtf(om.x); sq.y = __builtin_amdgcn_sqrtf(om.y);
        const f32x2 bb = sq * (ii * xc);
        avr[r] = av.x; avr[r + 1] = av.y; bvr[r] = bb.x; bvr[r + 1] = bb.y; }
}
__device__ __forceinline__ void lru_gates(const bf16* XCB, const float* XC, float* A_, float* B_, const bf16x8 (&wrf)[8], const bf16x8 (&wif)[8], const float brv, const float biv, const float sp8, int rb, int cbk, int jl, int hi) {
    float avr[16], bvr[16]; lru_gates_r(XCB, XC, avr, bvr, wrf, wif, brv, biv, sp8, rb, cbk, jl, hi);
#pragma unroll
    for (int r = 0; r < 16; ++r) { const int i = 32 * rb + crow(r, hi), j = 32 * cbk + jl; A_[i * 128 + j] = avr[r]; B_[i * 128 + j] = bvr[r]; }
}
__device__ __forceinline__ void lru_out(const float* B_, bf16* HG, const u32x4 (&gv)[2], size_t row0, int n, int tid) {
#pragma unroll
    for (int k = 0; k < 2; ++k) { const int e = tid + 512 * k, rw = e >> 4, q = e & 15; const f32x4 h0 = *(const f32x4*)(B_ + rw * 128 + q * 8), h1 = *(const f32x4*)(B_ + rw * 128 + q * 8 + 4);
        u32x4 w; w.x = pk2(h0.x * bflo(gv[k].x), h0.y * bfhi(gv[k].x)); w.y = pk2(h0.z * bflo(gv[k].y), h0.w * bfhi(gv[k].y));
        w.z = pk2(h1.x * bflo(gv[k].z), h1.y * bfhi(gv[k].z)); w.w = pk2(h1.z * bflo(gv[k].w), h1.w * bfhi(gv[k].w));
        *(u32x4*)(HG + (row0 + rw) * 1024 + n * 128 + q * 8) = w; }
}
#define LRU_SETUP() \
    float* A_ = (float*)(lds + L_AB); float* B_ = A_ + 64 * 128; float* XC = (float*)(lds + L_XC); bf16* XCB = (bf16*)(lds + L_XCB); float* SEGP = (float*)(lds + L_SEG); float* SEGH = SEGP + 512; \
    const int ch = tid & 127, seg = tid >> 7, c = n * 128 + ch; \
    const int cbk = wave & 3, rb = wave >> 2, jl = lane & 31, hi = lane >> 5, cgc = n * 128 + 32 * cbk + jl; \
    LruConsts K; K.w0 = P.convw[c]; K.w1 = P.convw[1024 + c]; K.w2 = P.convw[2048 + c]; K.w3 = P.convw[3072 + c]; K.cbv = P.convb[c]; \
    K.brv = P.br[cgc]; K.biv = P.bi[cgc]; K.sp8 = 8.0f * log1pf(__expf(-P.lam[cgc])); \
    bf16x8 wrf[8], wif[8]; \
    _Pragma("unroll") for (int ks = 0; ks < 8; ++ks) { const size_t o = ((size_t)(n * 128 + 32 * cbk + jl)) * 128 + 16 * ks + 8 * hi; wrf[ks] = *(const bf16x8*)(P.WRt + o); wif[ks] = *(const bf16x8*)(P.WIt + o); }

__device__ __forceinline__ void lru_prompt(const LruP& P, float* HLAST, bf16* HL, bf16* PC, unsigned char* lds, int tid, int lane, int wave, int b, int cI, int n) {
    LRU_SETUP();
    float Hrun = 0.f, Prun = 1.f;
    unsigned short xr[19];
    const bf16* xcol = P.XBR + (size_t)b * SEQ * 1024 + c;
#define LOADX(scn) do { const int tb_ = cI * 512 + (scn) * 64 + seg * 16 - 3; _Pragma("unroll") for (int i_ = 0; i_ < 19; ++i_) { const int t_ = tb_ + i_; const unsigned short v_ = xcol[(size_t)(t_ < 0 ? 0 : t_) * 1024]; xr[i_] = t_ < 0 ? (unsigned short)0 : v_; } } while (0)
    LOADX(0);
    for (int sc = 0; sc < 8; ++sc) {
        const size_t row0 = (size_t)b * SEQ + cI * 512 + sc * 64;
#pragma unroll
        for (int i = 0; i < 16; ++i) { const int jj = seg * 16 + i;
            const float xc = (((K.cbv + bf2f(xr[i]) * K.w0) + bf2f(xr[i + 1]) * K.w1) + bf2f(xr[i + 2]) * K.w2) + bf2f(xr[i + 3]) * K.w3;
            XC[jj * 128 + ch] = xc; XCB[jj * XCBS + ch] = (bf16)(pk2(xc, 0.f) & 0xffffu); }
        if (sc < 7) LOADX(sc + 1);
        u32x4 gv[2];
#pragma unroll
        for (int k = 0; k < 2; ++k) { const int e = tid + 512 * k, rw = e >> 4, q = e & 15; gv[k] = *(const u32x4*)(P.GS + (row0 + rw) * 1024 + n * 128 + q * 8); }
        __syncthreads();
        float av[16], bv[16];
        lru_gates_r(XCB, XC, av, bv, wrf, wif, K.brv, K.biv, K.sp8, rb, cbk, jl, hi);
        float gP[4], gH[4], qP[4], qH[4];
#pragma unroll
        for (int g = 0; g < 4; ++g) { float Hh = bv[4 * g], Pp = av[4 * g];
#pragma unroll
            for (int k = 1; k < 4; ++k) { Hh = av[4 * g + k] * Hh + bv[4 * g + k]; Pp *= av[4 * g + k]; }
            gP[g] = Pp; gH[g] = Hh; }
#pragma unroll
        for (int g = 0; g < 4; ++g) { qP[g] = __shfl_xor(gP[g], 32); qH[g] = __shfl_xor(gH[g], 32); }
        { float bP = 1.f, bH = 0.f;
#pragma unroll
          for (int g = 0; g < 4; ++g) { const float P0 = hi ? qP[g] : gP[g], H0 = hi ? qH[g] : gH[g], P1 = hi ? gP[g] : qP[g], H1 = hi ? gH[g] : qH[g];
              bH = P0 * bH + H0; bP *= P0; bH = P1 * bH + H1; bP *= P1; }
          if (hi == 0) { SEGP[rb * 128 + 32 * cbk + jl] = bP; SEGH[rb * 128 + 32 * cbk + jl] = bH; } }
        __syncthreads();
        { const int j = 32 * cbk + jl; const float P0b = SEGP[j], H0b = SEGH[j], P1b = SEGP[128 + j], H1b = SEGH[128 + j];
          float cur = rb ? P0b * Hrun + H0b : Hrun, pc = rb ? Prun * P0b : Prun;
          Hrun = P1b * (P0b * Hrun + H0b) + H1b; Prun = Prun * P0b * P1b;
#pragma unroll
          for (int g = 0; g < 4; ++g) { const float preP = hi ? qP[g] : 1.f, preH = hi ? qH[g] : 0.f, postP = hi ? 1.f : qP[g], postH = hi ? 0.f : qH[g];
              cur = preP * cur + preH; pc *= preP;
#pragma unroll
              for (int k = 0; k < 4; ++k) { const int r = 4 * g + k; cur = av[r] * cur + bv[r]; pc *= av[r]; bv[r] = cur; av[r] = pc; }
              cur = postP * cur + postH; pc *= postP; }
#pragma unroll
          for (int r = 0; r < 16; ++r) { const int i = 32 * rb + crow(r, hi); B_[i * 128 + j] = bv[r]; A_[i * 128 + j] = av[r]; }
          if (cI == 15 && sc == 7 && rb == 1 && hi == 1) { float* hl = HLAST + (size_t)(b * 1024 + n * 128 + j) * 2; hl[0] = bv[15]; hl[1] = av[15]; } }
        __syncthreads();
#pragma unroll
        for (int k = 0; k < 2; ++k) { const int e = tid + 512 * k, rw = e >> 4, q = e & 15; const size_t o = (row0 + rw) * 1024 + n * 128 + q * 8;
            const f32x4 h0 = *(const f32x4*)(B_ + rw * 128 + q * 8), h1 = *(const f32x4*)(B_ + rw * 128 + q * 8 + 4), p0 = *(const f32x4*)(A_ + rw * 128 + q * 8), p1 = *(const f32x4*)(A_ + rw * 128 + q * 8 + 4);
            const f32x4 g0 = {bflo(gv[k].x), bfhi(gv[k].x), bflo(gv[k].y), bfhi(gv[k].y)}, g1 = {bflo(gv[k].z), bfhi(gv[k].z), bflo(gv[k].w), bfhi(gv[k].w)};
            const f32x4 a0 = h0 * g0, a1 = h1 * g1, b0 = p0 * g0, b1 = p1 * g1;
            u32x4 w; w.x = pk2(a0.x, a0.y); w.y = pk2(a0.z, a0.w); w.z = pk2(a1.x, a1.y); w.w = pk2(a1.z, a1.w); *(u32x4*)(HL + o) = w;
            u32x4 v; v.x = pk2(b0.x, b0.y); v.y = pk2(b0.z, b0.w); v.z = pk2(b1.x, b1.y); v.w = pk2(b1.z, b1.w); *(u32x4*)(PC + o) = v; }
    }
#undef LOADX
    if (rb == 0 && hi == 0) { float* sp = P.SUM + ((size_t)(b * 16 + cI) * 1024 + n * 128 + 32 * cbk + jl) * 2; sp[0] = Prun; sp[1] = Hrun; }
    __syncthreads();
}
__device__ __forceinline__ void lru_fix(const LruP& P, const float* HLAST, bf16* HL, const bf16* PC, unsigned char* lds, int tid, int b, int cI, int n) {
    float* CAR = (float*)(lds + L_SEG);
    if (tid < 128) { const int c = n * 128 + tid; typedef float f32x2c __attribute__((ext_vector_type(2))); f32x2c sv[15]; float Hc = 0.f;
#pragma unroll
        for (int c2 = 0; c2 < 15; ++c2) { const int cc = c2 < cI ? c2 : 0; sv[c2] = *(const f32x2c*)(P.SUM + ((size_t)(b * 16 + cc) * 1024 + c) * 2); }
#pragma unroll
        for (int c2 = 0; c2 < 15; ++c2) if (c2 < cI) Hc = sv[c2].x * Hc + sv[c2].y;
        CAR[tid] = Hc;
        if (cI == 15) { const float* hl = HLAST + (size_t)(b * 1024 + c) * 2; P.hp[b * 1024 + c] = hl[0] + hl[1] * Hc; } }
    __syncthreads();
    const int q = tid & 15, r0 = tid >> 4;
    const f32x4 c0 = *(const f32x4*)(CAR + q * 8), c1 = *(const f32x4*)(CAR + q * 8 + 4);
    const size_t base = ((size_t)b * SEQ + cI * 512 + r0) * 1024 + n * 128 + q * 8;
#pragma unroll 1
    for (int it = 0; it < 16; it += 8) {
        u32x4 hv[8], pv[8];
#pragma unroll
        for (int k = 0; k < 8; ++k) { const size_t o = base + (size_t)(it + k) * 32 * 1024; hv[k] = *(const u32x4*)(HL + o); pv[k] = *(const u32x4*)(PC + o); }
#pragma unroll
        for (int k = 0; k < 8; ++k) { const size_t o = base + (size_t)(it + k) * 32 * 1024;
            f32x4 h0 = {bflo(hv[k].x), bfhi(hv[k].x), bflo(hv[k].y), bfhi(hv[k].y)}, h1 = {bflo(hv[k].z), bfhi(hv[k].z), bflo(hv[k].w), bfhi(hv[k].w)};
            const f32x4 p0 = {bflo(pv[k].x), bfhi(pv[k].x), bflo(pv[k].y), bfhi(pv[k].y)}, p1 = {bflo(pv[k].z), bfhi(pv[k].z), bflo(pv[k].w), bfhi(pv[k].w)};
            h0 = h0 + p0 * c0; h1 = h1 + p1 * c1;
            u32x4 w; w.x = pk2(h0.x, h0.y); w.y = pk2(h0.z, h0.w); w.z = pk2(h1.x, h1.y); w.w = pk2(h1.z, h1.w);
            *(u32x4*)(HL + o) = w; }
    }
    __syncthreads();
}

__device__ __forceinline__ void lru_sample(const LruP& P, unsigned char* lds, int tid, int lane, int wave, int n, int su) {
    LRU_SETUP();
    float* XS = (float*)(lds + L_AB);
    const size_t row0 = (size_t)MP + su * 64;
    u32x4 gv[2];
#pragma unroll
    for (int k = 0; k < 2; ++k) { const int e = tid + 512 * k, rw = e >> 4, q = e & 15; gv[k] = *(const u32x4*)(P.GS + (row0 + rw) * 1024 + n * 128 + q * 8); }
    for (int e = tid; e < 112 * 16; e += 512) { const int xr = e >> 4, q = e & 15, sq = xr / 7, k = xr - sq * 7, bs = su * 16 + sq; f32x4 f0, f1;
        if (k < 3) { const float* s = P.convst + ((size_t)bs * 3 + k) * 1024 + n * 128 + q * 8; f0 = *(const f32x4*)s; f1 = *(const f32x4*)(s + 4); }
        else { const u32x4 v = *(const u32x4*)(P.XBR + ((size_t)MP + bs * 4 + (k - 3)) * 1024 + n * 128 + q * 8); f0 = (f32x4){bflo(v.x), bfhi(v.x), bflo(v.y), bfhi(v.y)}; f1 = (f32x4){bflo(v.z), bfhi(v.z), bflo(v.w), bfhi(v.w)}; }
        *(f32x4*)(XS + xr * 128 + q * 8) = f0; *(f32x4*)(XS + xr * 128 + q * 8 + 4) = f1; }
    float h0v[4];
#pragma unroll
    for (int sq = 0; sq < 4; ++sq) h0v[sq] = P.lruh[(size_t)(su * 16 + seg * 4 + sq) * 1024 + c];
    __syncthreads();
#pragma unroll 4
    for (int i = 0; i < 16; ++i) { const int jj = seg * 16 + i; const int xb = (jj >> 2) * 7 + (jj & 3);
        const float xc = (((K.cbv + XS[xb * 128 + ch] * K.w0) + XS[(xb + 1) * 128 + ch] * K.w1) + XS[(xb + 2) * 128 + ch] * K.w2) + XS[(xb + 3) * 128 + ch] * K.w3;
        XC[jj * 128 + ch] = xc; XCB[jj * XCBS + ch] = (bf16)(pk2(xc, 0.f) & 0xffffu); }
    __syncthreads();
    lru_gates(XCB, XC, A_, B_, wrf, wif, K.brv, K.biv, K.sp8, rb, cbk, jl, hi);
    __syncthreads();
#pragma unroll
    for (int sq = 0; sq < 4; ++sq) { float h = h0v[sq];
#pragma unroll
        for (int t = 0; t < 4; ++t) { const int jj = (seg * 4 + sq) * 4 + t; h = A_[jj * 128 + ch] * h + B_[jj * 128 + ch]; B_[jj * 128 + ch] = h; }
        P.hs[(size_t)(su * 16 + seg * 4 + sq) * 1024 + c] = h; }
    __syncthreads();
    lru_out(B_, P.HG, gv, row0, n, tid);
    __syncthreads();
}

constexpr int A_KT = 0, KTS = 72, A_VT = 36864, VTS = 260, A_WSF = 70144, A_STG = 72192, STGS = 68;
constexpr int VTS_S = 164, AS_SET = 44032, AS_VT = 23040, AS_WSF = 88064, AS_STG = 90112;
struct AttP { const bf16* QB; const bf16* KB; const bf16* VB; const bf16* GS; bf16* OG; const float* sinks; const float* ck; const float* cv; float* ks; float* vs; };
#define CFENCE() asm volatile("" ::: "memory")

template <bool SAMPLE, int VS>
__device__ __forceinline__ void attn_block(const AttP& P, const bf16* KT, const bf16* VT, float* wsf, float* stg, int lane, const bf16x8 (&qr)[4], int i0, int kpos0, int qd, float slope2, float sink2,
                                           size_t orow0, int hcol0) {
    const int jl = lane & 31, hi = lane >> 5;
    f32x16 S[5];
    const bf16* kp = KT + (i0 + jl) * KTS + 8 * hi;
#pragma unroll
    for (int kb = 0; kb < 5; ++kb) { S[kb] = (f32x16){};
#pragma unroll
        for (int d0 = 0; d0 < 4; ++d0) { const bf16x8 kf = *(const bf16x8*)(kp + kb * 32 * KTS + 16 * d0); S[kb] = __builtin_amdgcn_mfma_f32_32x32x16_bf16(kf, qr[d0], S[kb], 0, 0, 0); }
        CFENCE(); }
    float m = sink2; const float c1 = 0.125f * LOG2E;
    int dq = qd - 4 * hi, kq = kpos0 + 4 * hi; asm volatile("" : "+v"(dq), "+v"(kq));
#pragma unroll
    for (int kb = 0; kb < 5; ++kb)
#pragma unroll
        for (int r = 0; r < 16; ++r) { const int x = 32 * kb + (r & 3) + 8 * (r >> 2), dist = dq - x; const bool valid = ((unsigned)dist < 128u) && (kq + x >= 0);
            const float s = valid ? S[kb][r] * c1 - slope2 * (float)dist : -1e30f; S[kb][r] = s; m = fmaxf(m, s); }
    m = fmaxf(m, __shfl_xor(m, 32));
    float ls = 0.f;
#pragma unroll
    for (int kb = 0; kb < 5; ++kb)
#pragma unroll
        for (int r = 0; r < 16; ++r) { const float p = __builtin_amdgcn_exp2f(S[kb][r] - m); S[kb][r] = p; ls += p; }
    ls += __shfl_xor(ls, 32); ls += __builtin_amdgcn_exp2f(sink2 - m);
    if (hi == 0) wsf[jl] = ls;
    constexpr int NPC = SAMPLE ? 2 : 4;
    u32x4 gv[NPC]; unsigned oo[NPC];
#pragma unroll
    for (int k = 0; k < NPC; ++k) { const int pc = lane + 64 * k, jq = pc >> 3, c8 = pc & 7;
        oo[k] = (unsigned)(SAMPLE ? (orow0 + (jq & 3)) * 1024 + hcol0 + (jq >> 2) * 64 + c8 * 8 : (orow0 + jq) * 1024 + hcol0 + c8 * 8); gv[k] = *(const u32x4*)(P.GS + oo[k]); }
    f32x16 O[2]; O[0] = (f32x16){}; O[1] = (f32x16){};
    const bf16* vp0 = VT + jl * VS + i0 + 4 * hi;
#pragma unroll
    for (int kb = 0; kb < 5; ++kb) {
#pragma unroll
        for (int s2 = 0; s2 < 2; ++s2) {
            u32x4 pw; pw.x = pk2(S[kb][8 * s2 + 0], S[kb][8 * s2 + 1]); pw.y = pk2(S[kb][8 * s2 + 2], S[kb][8 * s2 + 3]); pw.z = pk2(S[kb][8 * s2 + 4], S[kb][8 * s2 + 5]); pw.w = pk2(S[kb][8 * s2 + 6], S[kb][8 * s2 + 7]);
            const bf16x8 pf = __builtin_bit_cast(bf16x8, pw);
#pragma unroll
            for (int db = 0; db < 2; ++db) { const bf16* vp = vp0 + 32 * db * VS + 32 * kb + 16 * s2;
                const u32x2 lo = *(const u32x2*)vp, hh = *(const u32x2*)(vp + 8); const u32x4 vw = {lo.x, lo.y, hh.x, hh.y};
                O[db] = __builtin_amdgcn_mfma_f32_32x32x16_bf16(pf, __builtin_bit_cast(bf16x8, vw), O[db], 0, 0, 0); }
        }
        CFENCE(); }
    LDS_WAIT();
    const float* wl = wsf + 4 * hi;
#pragma unroll
    for (int r = 0; r < 16; ++r) { const int jr = (r & 3) + 8 * (r >> 2); const float rl = __builtin_amdgcn_rcpf(wl[jr]);
        stg[(jr + 4 * hi) * STGS + jl] = O[0][r] * rl; stg[(jr + 4 * hi) * STGS + 32 + jl] = O[1][r] * rl; }
    LDS_WAIT();
#pragma unroll
    for (int k = 0; k < NPC; ++k) { const int pc = lane + 64 * k, jq = pc >> 3, c8 = pc & 7; const f32x4 h0 = *(const f32x4*)(stg + jq * STGS + c8 * 8), h1 = *(const f32x4*)(stg + jq * STGS + c8 * 8 + 4);
        u32x4 w; w.x = pk2(h0.x * bflo(gv[k].x), h0.y * bfhi(gv[k].x)); w.y = pk2(h0.z * bflo(gv[k].y), h0.w * bfhi(gv[k].y));
        w.z = pk2(h1.x * bflo(gv[k].z), h1.y * bfhi(gv[k].z)); w.w = pk2(h1.z * bflo(gv[k].w), h1.w * bfhi(gv[k].w));
        *(u32x4*)(P.OG + oo[k]) = w; }
    LDS_WAIT();
}

__device__ __forceinline__ void attn_phase(const AttP& P, unsigned char* lds, int tid, int lane, int wave, int bx, int G) {
    {
        bf16* KT = (bf16*)(lds + A_KT); bf16* VT = (bf16*)(lds + A_VT); float* wsf = (float*)(lds + A_WSF) + wave * 64; float* stg = (float*)(lds + A_STG) + wave * (32 * STGS);
        u32x4 kreg[4], vreg[4];
#define ATT_PREF(uu) do { const int qb_ = (uu) & 63, kv_ = ((uu) >> 6) & 3, b_ = (uu) >> 8; _Pragma("unroll") for (int j_ = 0; j_ < 4; ++j_) { const int e_ = tid + 512 * j_, i_ = e_ >> 3, q_ = e_ & 7, kp_ = qb_ * 128 - 128 + i_; \
            const size_t o_ = ((size_t)b_ * SEQ + (kp_ < 0 ? 0 : kp_)) * 256 + kv_ * 64 + q_ * 8; kreg[j_] = *(const u32x4*)(P.KB + o_); vreg[j_] = *(const u32x4*)(P.VB + o_); \
            if (kp_ < 0) { kreg[j_] = (u32x4){0u, 0u, 0u, 0u}; vreg[j_] = kreg[j_]; } } } while (0)
        const int vb = (G % 8 == 0) ? (bx & 7) * (G >> 3) + (bx >> 3) : bx;
        if (vb < 512) ATT_PREF(vb);
        for (int u = vb; u < 512; u += G) {
            const int qb = u & 63, kv = (u >> 6) & 3, b = u >> 8, q0 = qb * 128;
            const int h = kv * 4 + (wave >> 1); const float slope2 = exp2f(-0.5f * (float)(h + 1)) * LOG2E, sink2 = P.sinks[h] * LOG2E;
            const int jl = lane & 31, hi = lane >> 5; bf16x8 qr0[4], qr1[4];
            { const bf16* qp = P.QB + ((size_t)b * SEQ + q0 + 64 * (wave & 1) + jl) * 1024 + h * 64 + 8 * hi;
#pragma unroll
              for (int d0 = 0; d0 < 4; ++d0) { qr0[d0] = *(const bf16x8*)(qp + 16 * d0); qr1[d0] = *(const bf16x8*)(qp + 32 * 1024 + 16 * d0); } }
#pragma unroll
            for (int j = 0; j < 4; ++j) { const int e = tid + 512 * j, i = e >> 3, q = e & 7; *(u32x4*)(KT + i * KTS + q * 8) = kreg[j]; const u32x4 vv = vreg[j];
                bf16* vd = VT + (q * 8) * VTS + i;
                vd[0] = (bf16)(vv.x & 0xffffu); vd[VTS] = (bf16)(vv.x >> 16); vd[2 * VTS] = (bf16)(vv.y & 0xffffu); vd[3 * VTS] = (bf16)(vv.y >> 16);
                vd[4 * VTS] = (bf16)(vv.z & 0xffffu); vd[5 * VTS] = (bf16)(vv.z >> 16); vd[6 * VTS] = (bf16)(vv.w & 0xffffu); vd[7 * VTS] = (bf16)(vv.w >> 16); }
            __syncthreads();
            if (u + G < 512) ATT_PREF(u + G);
            { const int qoff = 64 * (wave & 1), qa = q0 + qoff; const size_t rowq = (size_t)b * SEQ + qa;
              attn_block<false, VTS>(P, KT, VT, wsf, stg, lane, qr0, qoff, qa - 128, 128 + jl, slope2, sink2, rowq, h * 64); }
            { const int qoff = 64 * (wave & 1) + 32, qa = q0 + qoff; const size_t rowq = (size_t)b * SEQ + qa;
              attn_block<false, VTS>(P, KT, VT, wsf, stg, lane, qr1, qoff, qa - 128, 128 + jl, slope2, sink2, rowq, h * 64); }
            __syncthreads();
        }
#undef ATT_PREF
    }
    for (int it = bx; it < 256; it += G) {
        const int jn = tid >> 8, rn = tid & 255, in_ = 128 + (rn >> 6), dn = rn & 63, usn = 2 * it + jn; const size_t on = ((size_t)MP + (usn >> 2) * 4 + (in_ - 128)) * 256 + (usn & 3) * 64 + dn;
        const bf16 knew = P.KB[on], vnew = P.VB[on];
        bf16x8 qs[4]; float slope2 = 0.f, sink2 = 0.f; int tq = 0; size_t rowq = 0; int kvs = 0;
        if (wave < 2) { const int us = 2 * it + wave, kv = us & 3, b = us >> 2, jl = lane & 31, hi = lane >> 5, j = jl & 15, hh = j >> 2, t = j & 3, h = kv * 4 + hh;
            slope2 = exp2f(-0.5f * (float)(h + 1)) * LOG2E; sink2 = P.sinks[h] * LOG2E; tq = t; rowq = (size_t)MP + b * 4; kvs = kv;
            const bf16* qp = P.QB + (rowq + t) * 1024 + h * 64 + 8 * hi;
#pragma unroll
            for (int d0 = 0; d0 < 4; ++d0) qs[d0] = *(const bf16x8*)(qp + 16 * d0); }
        { f32x4 kfv[8], vfv[8];
#pragma unroll
          for (int k = 0; k < 8; ++k) { const int e = tid + 512 * k, j = e >> 11, r = e & 2047, i = r >> 4, q4 = r & 15, us = 2 * it + j, kv = us & 3, b = us >> 2;
              const size_t o = (((size_t)b * 128 + i) * 4 + kv) * 64 + q4 * 4; kfv[k] = *(const f32x4*)(P.ck + o); vfv[k] = *(const f32x4*)(P.cv + o); }
#pragma unroll
          for (int k = 0; k < 8; ++k) { const int e = tid + 512 * k, j = e >> 11, r = e & 2047, i = r >> 4, q4 = r & 15, us = 2 * it + j, kv = us & 3, b = us >> 2;
              const f32x4 kf = kfv[k], vf = vfv[k];
              if (i >= 4) { const size_t oo = (((size_t)b * 128 + i - 4) * 4 + kv) * 64 + q4 * 4; *(f32x4*)(P.ks + oo) = kf; *(f32x4*)(P.vs + oo) = vf; }
              bf16* KTs = (bf16*)(lds + j * AS_SET); bf16* VTs = (bf16*)(lds + j * AS_SET + AS_VT);
              u32x2 kw; kw.x = pk2(kf.x, kf.y); kw.y = pk2(kf.z, kf.w); *(u32x2*)(KTs + i * KTS + q4 * 4) = kw;
              const unsigned v01 = pk2(vf.x, vf.y), v23 = pk2(vf.z, vf.w); bf16* vd = VTs + (q4 * 4) * VTS_S + i;
              vd[0] = (bf16)(v01 & 0xffffu); vd[VTS_S] = (bf16)(v01 >> 16); vd[2 * VTS_S] = (bf16)(v23 & 0xffffu); vd[3 * VTS_S] = (bf16)(v23 >> 16); } }
        { bf16* KTs = (bf16*)(lds + jn * AS_SET); bf16* VTs = (bf16*)(lds + jn * AS_SET + AS_VT); KTs[in_ * KTS + dn] = knew; VTs[dn * VTS_S + in_] = vnew; }
        for (int e = tid; e < 2 * 28 * 64; e += 512) { const int j = e / (28 * 64), r = e - j * 28 * 64, i = 132 + (r >> 6), d = r & 63;
            bf16* KTs = (bf16*)(lds + j * AS_SET); bf16* VTs = (bf16*)(lds + j * AS_SET + AS_VT); KTs[i * KTS + d] = 0; VTs[d * VTS_S + i] = 0; }
        __syncthreads();
        if (wave < 2) { const bf16* KTs = (const bf16*)(lds + wave * AS_SET); const bf16* VTs = (const bf16*)(lds + wave * AS_SET + AS_VT);
            float* wsf = (float*)(lds + AS_WSF) + wave * 64; float* stg = (float*)(lds + AS_STG) + wave * (32 * STGS);
            attn_block<true, VTS_S>(P, KTs, VTs, wsf, stg, lane, qs, 0, 0, 128 + tq, slope2, sink2, rowq, kvs * 256); }
        __syncthreads();
    }
}

__device__ __forceinline__ void final_norm(float* Y, const bf16* Hb, const float* ss, const float* g, int lane, int wave, int bx, int G) {
    const int gw = bx * 8 + wave, NGW = G * 8;
    f32x4 gv[4];
#pragma unroll
    for (int j = 0; j < 2; ++j) { gv[2 * j] = *(const f32x4*)(g + 512 * j + 8 * lane); gv[2 * j + 1] = *(const f32x4*)(g + 512 * j + 8 * lane + 4); }
    u32x4 cur[2], nxt[2]; float sc = 0.f, sn = 0.f;
    if (gw < MT) { cur[0] = *(const u32x4*)(Hb + (size_t)gw * 1024 + 8 * lane); cur[1] = *(const u32x4*)(Hb + (size_t)gw * 1024 + 512 + 8 * lane); sc = ss[gw]; }
    for (int m = gw; m < MT; m += NGW) {
        const int mn = m + NGW;
        if (mn < MT) { nxt[0] = *(const u32x4*)(Hb + (size_t)mn * 1024 + 8 * lane); nxt[1] = *(const u32x4*)(Hb + (size_t)mn * 1024 + 512 + 8 * lane); sn = ss[mn]; }
        const float rs = rsqrtf(sc * (1.0f / 1024.0f) + EPSN);
#pragma unroll
        for (int j = 0; j < 2; ++j) { const u32x4 w = cur[j]; float* yp = Y + (size_t)m * 1024 + 512 * j + 8 * lane;
            *(f32x4*)yp = (f32x4){bflo(w.x), bfhi(w.x), bflo(w.y), bfhi(w.y)} * rs * gv[2 * j]; *(f32x4*)(yp + 4) = (f32x4){bflo(w.z), bfhi(w.z), bflo(w.w), bfhi(w.w)} * rs * gv[2 * j + 1]; }
        cur[0] = nxt[0]; cur[1] = nxt[1]; sc = sn;
    }
}

template <int NC>
__device__ __forceinline__ void sg_stage(unsigned char* lds, const bf16* Bt, int K, int c0, int tid) {
    const int ks = K + 8, cpr = K >> 3;
    __syncthreads();
    for (int e = tid; e < 16 * NC * cpr; e += 512) { const int r = e / cpr, q = e - r * cpr; *(u32x4*)((bf16*)lds + r * ks + q * 8) = *(const u32x4*)(Bt + (size_t)(c0 + r) * K + q * 8); }
    __syncthreads();
}
template <int NC, int K>
__device__ __forceinline__ void sg_acc(f32x4 (&acc)[NC], const bf16* A, const unsigned char* lds, int r0, int lane) {
    const int fr = lane & 15, fq = lane >> 4; constexpr int ks = K + 8;
    const bf16* ap = A + (size_t)(r0 + fr) * K + 8 * fq; const bf16* bp = (const bf16*)lds + fr * ks + 8 * fq;
    bf16x8 af[K / 32];
#pragma unroll
    for (int t = 0; t < K / 32; ++t) af[t] = *(const bf16x8*)(ap + 32 * t);
#pragma unroll
    for (int t = 0; t < K / 32; ++t)
#pragma unroll
        for (int j = 0; j < NC; ++j) { const bf16x8 bfr = *(const bf16x8*)(bp + j * 16 * ks + 32 * t); acc[j] = __builtin_amdgcn_mfma_f32_16x16x32_bf16(bfr, af[t], acc[j], 0, 0, 0); }
}
__device__ __forceinline__ void st_bf4(bf16* p, f32x4 v) { u32x2 w; w.x = pk2(v[0], v[1]); w.y = pk2(v[2], v[3]); *(u32x2*)p = w; }
__device__ __forceinline__ f32x4 ld_bf4(const bf16* p) { const u32x2 w = *(const u32x2*)p; return (f32x4){bflo(w.x), bfhi(w.x), bflo(w.y), bfhi(w.y)}; }
__device__ __forceinline__ void ss_add(float* ssp, int row, f32x4 h, int fq) { float sq = (h[0] * h[0] + h[1] * h[1]) + (h[2] * h[2] + h[3] * h[3]); sq += __shfl_xor(sq, 16); sq += __shfl_xor(sq, 32); if (fq == 0) atomicAdd(ssp + row, sq); }
__device__ __forceinline__ void s_inA(unsigned char* lds, const bf16* XA, const bf16* Wt, const float* ss, bf16* XBR, bf16* GS, float* conv_s, int tid, int wave, int lane, int bx, int G) {
    const int fr = lane & 15, fq = lane >> 4;
    for (int p = bx; p < 256; p += G) { const int r0 = MP + 128 * (p & 3) + 16 * wave, c0 = 32 * (p >> 2), row = r0 + fr, s = row - MP, t = s & 3;
        sg_stage<2>(lds, Wt, 1024, c0, tid);
        f32x4 acc[2] = {}; sg_acc<2, 1024>(acc, XA, lds, r0, lane);
        const float rs = rsqrtf(ss[row] * (1.0f / 1024.0f) + EPSN);
#pragma unroll
        for (int j = 0; j < 2; ++j) { const int col = c0 + 16 * j + 4 * fq; f32x4 v = acc[j] * rs;
            if (col < 1024) { st_bf4(XBR + (size_t)row * 1024 + col, v); if (t >= 1) *(f32x4*)(conv_s + (size_t)((s >> 2) * 3 + (t - 1)) * 1024 + col) = v; }
            else { v[0] = siluf_(v[0]); v[1] = siluf_(v[1]); v[2] = siluf_(v[2]); v[3] = siluf_(v[3]); st_bf4(GS + (size_t)row * 1024 + col - 1024, v); } } }
}
__device__ __forceinline__ void s_res(unsigned char* lds, const bf16* A, const bf16* Wt, const bf16* res, bf16* HB, float* ssout, int tid, int wave, int lane, int bx, int G) {
    const int fr = lane & 15, fq = lane >> 4;
    for (int p = bx; p < 256; p += G) { const int r0 = MP + 128 * (p & 3) + 16 * wave, c0 = 16 * (p >> 2), row = r0 + fr, col = c0 + 4 * fq;
        const f32x4 rv = ld_bf4(res + (size_t)row * 1024 + col);
        sg_stage<1>(lds, Wt, 1024, c0, tid);
        f32x4 acc[1] = {}; sg_acc<1, 1024>(acc, A, lds, r0, lane);
        const f32x4 h = rv + acc[0]; st_bf4(HB + (size_t)row * 1024 + col, h); ss_add(ssout, row, h, fq); }
}
__device__ __forceinline__ void s_ple(unsigned char* lds, const bf16* PBl, const bf16* Wpp, const bf16* Hin, const bf16* Wpg, const float* ssin, bf16* HB, float* ssout, int tid, int wave, int lane, int bx, int G) {
    const int fr = lane & 15, fq = lane >> 4;
    for (int p = bx; p < 256; p += G) { const int r0 = MP + 128 * (p & 3) + 16 * wave, c0 = 16 * (p >> 2), row = r0 + fr, col = c0 + 4 * fq;
        f32x4 hv = ld_bf4(Hin + (size_t)row * 1024 + col); const float rs = rsqrtf(ssin[row] * (1.0f / 1024.0f) + EPSN);
        sg_stage<1>(lds, Wpp, 256, c0, tid); f32x4 ap[1] = {}; sg_acc<1, 256>(ap, PBl, lds, r0, lane);
        sg_stage<1>(lds, Wpg, 1024, c0, tid); f32x4 ag[1] = {}; sg_acc<1, 1024>(ag, Hin, lds, r0, lane);
#pragma unroll
        for (int e = 0; e < 4; ++e) hv[e] += sigmoidf_(ag[0][e] * rs) * ap[0][e];
        st_bf4(HB + (size_t)row * 1024 + col, hv); ss_add(ssout, row, hv, fq); }
}


#define LAS __attribute__((address_space(3)))
#define XB_TMO      128
#define XB_XCNT(j)  (256  + 64 * (j))
#define XB_XSUB(j)  (1280 + 64 * (j))
#define XB_XGEN(j)  (2304 + 64 * (j))
#define XB_TOP      3328
#define XB_TOPGEN   3392
#define XCD_BAR_WORDS 3456
#define XB_SPIN_CAP (1u << 18)

__device__ __forceinline__ unsigned xb_ld(unsigned* p)              { return __hip_atomic_load(p, __ATOMIC_RELAXED, __HIP_MEMORY_SCOPE_AGENT); }
__device__ __forceinline__ unsigned xb_add(unsigned* p, unsigned v) { return __hip_atomic_fetch_add(p, v, __ATOMIC_RELAXED, __HIP_MEMORY_SCOPE_AGENT); }
__device__ __forceinline__ unsigned xb_xcc_id() { return (unsigned)__builtin_amdgcn_s_getreg((3 << 11) | 20) & 0xFu; }
#define XB_SPIN(cond, bar) do { unsigned _sp = 0; while (cond) { __builtin_amdgcn_s_sleep(1); \
    if ((++_sp & 255u) == 0u) { if (xb_ld(&(bar)[XB_TMO])) break; if (_sp > XB_SPIN_CAP) { atomicAdd(&(bar)[XB_TMO], 1u); break; } } } } while (0)

struct XcdBarrier {
    unsigned* bar; unsigned x;
    volatile LAS unsigned* st;
};

__device__ __forceinline__ XcdBarrier xcd_barrier_post(unsigned* bar, volatile LAS unsigned* st) {
    XcdBarrier b; b.bar = bar; b.x = xb_xcc_id(); b.st = st;
    if (threadIdx.x == 0) (void)xb_add(&bar[XB_XCNT(b.x)], 1u);
    return b;
}
__device__ __forceinline__ void xcd_barrier_complete(unsigned* bar, unsigned x, unsigned& nloc, unsigned& nx) {
    const unsigned G = gridDim.x * gridDim.y * gridDim.z;
    unsigned sum, cnt, mine, sp = 0u;
    for (;;) {
        sum = 0u; cnt = 0u; mine = 0u;
#pragma unroll
        for (unsigned j = 0; j < 16; ++j) { const unsigned c = xb_ld(&bar[XB_XCNT(j)]); sum += c; cnt += (c > 0u) ? 1u : 0u; mine = (j == x) ? c : mine; }
        if (sum == G) break;
        __builtin_amdgcn_s_sleep(1);
        if ((++sp & 255u) == 0u) { if (xb_ld(&bar[XB_TMO])) break; if (sp > XB_SPIN_CAP) { atomicAdd(&bar[XB_TMO], 1u); break; } }
    }
    nloc = mine > 0u ? mine : 1u; nx = cnt > 0u ? cnt : 1u;
}

__device__ __forceinline__ void xcd_barrier(const XcdBarrier& b) {
    asm volatile("s_waitcnt vmcnt(0)" ::: "memory");
    __syncthreads();
    if (threadIdx.x == 0) {
        unsigned* bar = b.bar;
        __builtin_amdgcn_s_waitcnt(0);
        unsigned nloc = b.st[0], nx = b.st[1];
        if (nloc == 0u) { xcd_barrier_complete(bar, b.x, nloc, nx); b.st[0] = nloc; b.st[1] = nx; }
        const unsigned old = xb_add(&bar[XB_XSUB(b.x)], 1u);
        const unsigned gen = old / nloc;
        if (old + 1u == (gen + 1u) * nloc) {
            __builtin_amdgcn_fence(__ATOMIC_RELEASE, "agent");
            asm volatile("s_waitcnt vmcnt(0)" ::: "memory");
            const unsigned og = xb_add(&bar[XB_TOP], 1u);
            const unsigned tg = og / nx;
            if (og + 1u == (tg + 1u) * nx) xb_add(&bar[XB_TOPGEN], 1u);
            else XB_SPIN(xb_ld(&bar[XB_TOPGEN]) == tg, bar);
            __builtin_amdgcn_fence(__ATOMIC_ACQUIRE, "agent");
            xb_add(&bar[XB_XGEN(b.x)], 1u);
            asm volatile("s_waitcnt vmcnt(0)" ::: "memory");
        } else {
            XB_SPIN(xb_ld(&bar[XB_XGEN(b.x)]) == gen, bar);
            __builtin_amdgcn_fence(__ATOMIC_ACQUIRE, "agent");
            asm volatile("s_waitcnt vmcnt(0)" ::: "memory");
        }
    }
    __syncthreads();
}

#ifndef GSYNC_SEAM0
#define GSYNC_SEAM0 0
#endif
constexpr size_t WS_BAR = 2 * MiB, BAR_BYTES = 16384;
constexpr int MISC_OFF = LDS_BYTES - 128;
constexpr int NPH = 11;
__global__ void __launch_bounds__(512, 2) mk_fwd(Args a) {
    extern __shared__ __attribute__((aligned(16))) unsigned char lds[];
#define TIDS() int tid = threadIdx.x; asm volatile("" : "+v"(tid)); const int lane = tid & 63, wave = __builtin_amdgcn_readfirstlane(tid >> 6); (void)lane; (void)wave
    const int G = gridDim.x, bx = blockIdx.x;
    cg::grid_group grid = cg::this_grid();
    unsigned char* ws = a.ws;
    const int lo = a.ph_lo, hi = a.ph_hi;
#ifndef PH_MASK
#define PH_MASK 0x7ff
#endif
#define IN(k) (((PH_MASK >> (k)) & 1) && lo <= (k) && (k) < hi)
#ifndef REP_MASK
#define REP_MASK 0
#endif
#define REPLOOP(k) for (int rep = ((REP_MASK >> (k)) & 1) ? 0 : 1; rep < 2; ++rep)
#define SEAM(k) do { if (IN(k) && IN((k) + 1)) { if (GSYNC_SEAM0 && (k) == 0) grid.sync(); else xcd_barrier(bar); } } while (0)
    if (lo < 0) grid.sync();
    PG8_LAS unsigned char* glds = (PG8_LAS unsigned char*)lds;
    volatile LAS unsigned* MISC = (volatile LAS unsigned*)(glds + MISC_OFF);
    if (threadIdx.x < 32) MISC[threadIdx.x] = 0u;
    __syncthreads();
    XcdBarrier bar; bar.bar = (unsigned*)(ws + WS_BAR); bar.x = 0; bar.st = nullptr;
    if (hi - lo > 1) bar = xcd_barrier_post((unsigned*)(ws + WS_BAR), MISC);
    float* SS = (float*)(ws + WS_SS);
    bf16* SA = (bf16*)(ws + WS_SA); bf16* SB = (bf16*)(ws + WS_SB); bf16* SC = (bf16*)(ws + WS_SC); bf16* SD = (bf16*)(ws + WS_SD); bf16* SE = (bf16*)(ws + WS_SE); bf16* KBF = (bf16*)(ws + WS_KV); bf16* VBF = KBF + (size_t)MT * 256;
    bf16* PB = (bf16*)(ws + WS_PB);
    float* out = a.out; float* SSD = SS + 5 * MT; (void)SSD;

    if (IN(0)) { TIDS(); REPLOOP(0) p0_prologue(a, lds, tid, lane, wave, bx, G); }
    SEAM(0);
    if (IN(1)) REPLOOP(1) {
        { pg8::Gemm g{SA, (const bf16*)(ws + WS_W1), MP, 2048, 1024}; pg8::StaticOrder S; S.init(MP, 2048, G, bx);
          pg8::EpiInA E{SS, SB, SC, out + O_CONVP, out + O_CONVS};
          pg8::gemm_phase<pg8::EpiInA, pg8::StaticOrder, true, true>(glds, g, S, E); }
        { TIDS(); s_inA(lds, SA, (const bf16*)(ws + WS_W1), SS, SB, SC, out + O_CONVS, tid, wave, lane, bx, G); }
    }
    SEAM(1);
    LruP LP{SB, SC, SD, (const bf16*)(ws + WS_WR), (const bf16*)(ws + WS_WI), a.in[I_CONVW], a.in[I_CONVB], a.in[I_BR], a.in[I_BI], a.in[I_LAM], a.in[I_LRUH], a.in[I_CONVST],
            (float*)(ws + WS_SUM), out + O_HP, out + O_HS};
    float* HLAST = (float*)(ws + WS_SUM + 512 * 1024);
    if (IN(2)) {
        TIDS();
        REPLOOP(2) for (int u = bx; u < 256; u += G) { const int n = u & 7, cI = (u >> 3) & 15, b = u >> 7; lru_prompt(LP, HLAST, SD, SE, lds, tid, lane, wave, b, cI, n); }
    }
    SEAM(2);
    if (IN(3)) {
        TIDS();
        REPLOOP(3) for (int u = bx; u < 320; u += G) {
            if (u < 256) { const int n = u & 7, cI = (u >> 3) & 15, b = u >> 7; lru_fix(LP, HLAST, SD, SE, lds, tid, b, cI, n); }
            else { const int v = u - 256; lru_sample(LP, lds, tid, lane, wave, v & 7, v >> 3); }
        }
    }
    SEAM(3);
    if (IN(4)) REPLOOP(4) {
        { pg8::Gemm g{SD, (const bf16*)(ws + WS_WOA), MP, 1024, 1024}; pg8::StaticOrder S; S.init(MP, 1024, G, bx);
          pg8::EpiRes E{SA, SB, rep ? SS + MT : SSD};
          pg8::gemm_phase<pg8::EpiRes, pg8::StaticOrder, true, true>(glds, g, S, E); }
        { TIDS(); s_res(lds, SD, (const bf16*)(ws + WS_WOA), SA, SB, rep ? SS + MT : SSD, tid, wave, lane, bx, G); }
    }
    SEAM(4);
    if (IN(5)) REPLOOP(5) {
        { pg8::Gemm g{PB, (const bf16*)(ws + WS_WPP0), MP, 1024, 256}; pg8::StaticOrder S; S.init(MP, 1024, G, bx); pg8::EpiPP E{SC};
          pg8::gemm_phase<pg8::EpiPP, pg8::StaticOrder, true, true>(glds, g, S, E); }
        __syncthreads();
        { pg8::Gemm g{SB, (const bf16*)(ws + WS_WPG0), MP, 1024, 1024}; pg8::StaticOrder S; S.init(MP, 1024, G, bx); pg8::EpiPle E{SS + MT, SB, SC, SA, rep ? SS + 2 * MT : SSD};
          pg8::gemm_phase<pg8::EpiPle, pg8::StaticOrder, true, true>(glds, g, S, E); }
        { TIDS(); s_ple(lds, PB, (const bf16*)(ws + WS_WPP0), SB, (const bf16*)(ws + WS_WPG0), SS + MT, SA, rep ? SS + 2 * MT : SSD, tid, wave, lane, bx, G); }
    }
    SEAM(5);
    if (IN(6)) REPLOOP(6) {
        { pg8::Gemm g{SA, (const bf16*)(ws + WS_WINB), MT, 2560, 1024}; pg8::StaticOrder S; S.init(MT, 2560, G, bx);
          pg8::EpiInB E{SS + 2 * MT, SB, KBF, VBF, SC, out + O_KP, out + O_VP, out + O_KS, out + O_VS};
          pg8::gemm_phase<pg8::EpiInB, pg8::StaticOrder, true, true>(glds, g, S, E); }
        __syncthreads();
        { const int nbig = (MT / 256) * 10, first = nbig - (nbig / G) * G;
          pg8::Gemm g{PB + (size_t)MT * 256, (const bf16*)(ws + WS_WPP1), MP, 1024, 256}; pg8::SubsetOrder S{4, 256, G - first, bx >= first ? bx - first : -1}; pg8::EpiPP E{SE};
          pg8::gemm_phase<pg8::EpiPP, pg8::SubsetOrder, true, true>(glds, g, S, E); }
    }
    SEAM(6);
    if (IN(7)) {
        TIDS();
        AttP AP{SB, KBF, VBF, SC, SD, a.in[I_SINKS], a.in[I_CK], a.in[I_CV], out + O_KS, out + O_VS};
        REPLOOP(7) attn_phase(AP, lds, tid, lane, wave, bx, G);
    }
    SEAM(7);
    if (IN(8)) REPLOOP(8) {
        { pg8::Gemm g{SD, (const bf16*)(ws + WS_WOB), MP, 1024, 1024}; pg8::StaticOrder S; S.init(MP, 1024, G, bx);
          pg8::EpiRes E{SA, SB, rep ? SS + 3 * MT : SSD};
          pg8::gemm_phase<pg8::EpiRes, pg8::StaticOrder, true, true>(glds, g, S, E); }
        { TIDS(); s_res(lds, SD, (const bf16*)(ws + WS_WOB), SA, SB, rep ? SS + 3 * MT : SSD, tid, wave, lane, bx, G); }
    }
    SEAM(8);
    if (IN(9)) REPLOOP(9) {
        { pg8::Gemm g{SB, (const bf16*)(ws + WS_WPG1), MP, 1024, 1024}; pg8::StaticOrder S; S.init(MP, 1024, G, bx); pg8::EpiPle E{SS + 3 * MT, SB, SE, SA, rep ? SS + 4 * MT : SSD};
          pg8::gemm_phase<pg8::EpiPle, pg8::StaticOrder, true, true>(glds, g, S, E); }
        { TIDS(); s_ple(lds, PB + (size_t)MT * 256, (const bf16*)(ws + WS_WPP1), SB, (const bf16*)(ws + WS_WPG1), SS + 3 * MT, SA, rep ? SS + 4 * MT : SSD, tid, wave, lane, bx, G); }
    }
    SEAM(9);
    if (IN(10)) { TIDS(); REPLOOP(10) final_norm(out + O_Y, SA, SS + 4 * MT, a.in[I_FNORMG], lane, wave, bx, G); }
#undef IN
#undef SEAM
}

#ifndef MK_N_LAUNCHES
#define MK_N_LAUNCHES 1
#endif
extern "C" void kernel_launch(void* const* d_in, const int* in_sizes, int n_in, void* d_out, int out_size, void* d_ws, size_t ws_size, hipStream_t stream) {
    static int grid = 0;
    if (grid == 0) {
        if (n_in != 25 || (size_t)out_size != O_END || ws_size < WS_END) { fprintf(stderr, "kernel_launch: unexpected shapes (n_in %d, out %d, ws %zu)\n", n_in, out_size, ws_size); grid = -1; return; }
        int dev = 0, cus = 0, per_cu = 0;
        if (hipGetDevice(&dev) != hipSuccess || hipDeviceGetAttribute(&cus, hipDeviceAttributeMultiprocessorCount, dev) != hipSuccess) { grid = -1; return; }
        if (hipFuncSetAttribute((const void*)mk_fwd, hipFuncAttributeMaxDynamicSharedMemorySize, LDS_BYTES) != hipSuccess) { fprintf(stderr, "kernel_launch: hipFuncSetAttribute failed\n"); grid = -1; return; }
        if (hipOccupancyMaxActiveBlocksPerMultiprocessor(&per_cu, (const void*)mk_fwd, 512, LDS_BYTES) != hipSuccess || per_cu < 1) { fprintf(stderr, "kernel_launch: occupancy query says %d\n", per_cu); per_cu = 1; }
        (void)hipGetLastError();
        grid = cus * (per_cu > 1 ? 1 : per_cu);
    }
    if (grid < 0) return;
    Args a{};
    for (int i = 0; i < 25; ++i) a.in[i] = (const float*)d_in[i];
    a.out = (float*)d_out; a.ws = (unsigned char*)d_ws;
    if (MK_N_LAUNCHES == 1) {
        if (hipMemsetAsync((char*)d_ws + WS_BAR, 0, BAR_BYTES, stream) != hipSuccess) { fprintf(stderr, "kernel_launch: memset failed\n"); return; }
        a.ph_lo = 0; a.ph_hi = NPH;
        void* args[] = {&a};
        hipError_t e = hipLaunchCooperativeKernel((const void*)mk_fwd, dim3(grid), dim3(512), args, LDS_BYTES, stream);
        if (e != hipSuccess) fprintf(stderr, "cooperative launch failed: %s (grid %d)\n", hipGetErrorString(e), grid);
    } else {
        for (int p = 0; p < NPH; ++p) { a.ph_lo = p; a.ph_hi = p + 1; hipLaunchKernelGGL(mk_fwd, dim3(grid), dim3(512), LDS_BYTES, stream, a); }
    }
}
```

```cpp
#include <hip/hip_runtime.h>
#include <hip/hip_cooperative_groups.h>
#include <cstdio>
#include <cstdint>
namespace cg = cooperative_groups;
namespace pg8 {
#define PG8_LAS __attribute__((address_space(3)))
typedef unsigned short bf16_t;
typedef short bf16x8 __attribute__((ext_vector_type(8)));
typedef float f32x4 __attribute__((ext_vector_type(4)));
typedef unsigned u32x4 __attribute__((ext_vector_type(4)));
constexpr int BM = 256, BK = 64, HALF = 128, HTB = HALF * BK * 2  , STAGE_BYTES = 8 * HTB, NXCD = 8, WGM = 8;

__host__ __device__ __forceinline__ int lds_byte(int r, int c) { const int st = (r >> 4) * 2 + (c >> 5), rr = r & 15, cc = c & 31, ob = rr * 64 + cc * 2; return st * 1024 + (ob ^ (((ob >> 9) & 1) << 5)); }
__host__ __device__ __forceinline__ void stage_rc(int b, int& R, int& C) { const int st = b / 1024, sb = b % 1024, swz = sb ^ (((sb >> 9) & 1) << 5); R = (st >> 1) * 16 + swz / 64; C = (st & 1) * 32 + (swz % 64) / 2; }
__host__ __device__ __forceinline__ int perm32(int rho) { const int n = rho >> 4, i = rho & 15; return 8 * (i >> 2) + 4 * n + (i & 3); }

struct Unit { int pm, pn; };
struct Gemm { const bf16_t* A; const bf16_t* Bt; int M, N, K; };

struct StaticOrder {
    int nM, nN, nwg, G, c;
    __host__ __device__ void init(int M, int N, int G_, int c_) { nM = M / BM; nN = N / BM; nwg = nM * nN; G = G_; c = c_; }
    __host__ __device__ bool next(int i, Unit& u) const {
        const long L = (long)i * G + c; if (L >= nwg) return false;
        int wgid = (int)L; { const int q = nwg / NXCD, r = nwg % NXCD, xcd = wgid % NXCD, off = wgid / NXCD; wgid = (xcd < r ? xcd * (q + 1) : r * (q + 1) + (xcd - r) * q) + off; }
        const int nig = WGM * nN, gid = wgid / nig, fm = gid * WGM, gsz = (nM - fm) < WGM ? (nM - fm) : WGM;
        u.pm = fm + ((wgid % nig) % gsz); u.pn = (wgid % nig) / gsz; return true;
    }
    __device__ __forceinline__ void a_ready(const Unit&) const {}
    __device__ __forceinline__ void done(const Unit&) const {}
};

__device__ __forceinline__ unsigned cvt_pk_bf16(float lo, float hi) { unsigned r; asm volatile("v_cvt_pk_bf16_f32 %0, %1, %2" : "=v"(r) : "v"(lo), "v"(hi)); return r; }
template <class Epi, class Sched, bool ALIGN_EPI = false, bool SP2 = false>
__device__ __forceinline__ void gemm_phase(PG8_LAS unsigned char* lds, const Gemm g, const Sched& S, const Epi& E) {
    int tid_ = threadIdx.x; asm volatile("" : "+v"(tid_));
    const int tid = tid_, wid = __builtin_amdgcn_readfirstlane(tid >> 6), lane = tid & 63, wr = wid >> 2, wc = wid & 3, fr = lane & 15, fq = lane >> 4;
    const int K = g.K, nt = K / BK;
    unsigned voffA[2], voffB[2];
#pragma unroll
    for (int i = 0; i < 2; ++i) { int R, C; stage_rc(tid * 16 + i * 8192, R, C); const int Rb = Epi::PERM ? ((R & ~31) + perm32(R & 31)) : R;
        voffA[i] = (unsigned)(R * K + C) * 2u; voffB[i] = (unsigned)(Rb * K + C) * 2u; }
    const size_t kstep = (size_t)(BK * 2);
    const size_t hstep = (size_t)HALF * K * 2;
    const size_t tstep = 2 * hstep;
    const unsigned ldsw = (unsigned)wid * 1024u;
    const int aoff = lds_byte(wr * 64 + fr, fq * 8), boff = lds_byte(wc * 32 + fr, fq * 8);
#define PG8_SA(b, h) (((b) * 2 + (h)) * HTB)
#define PG8_SB(b, h) ((4 + (b) * 2 + (h)) * HTB)
#define PG8_STAGE(bufoff, gbase, voff) do { _Pragma("unroll") for (int _i = 0; _i < 2; ++_i) \
        __builtin_amdgcn_global_load_lds((const unsigned*)((const char*)(gbase) + (voff)[_i]), (PG8_LAS unsigned*)(lds + (bufoff) + ldsw + _i * 8192), 16, 0, 0); } while (0)
#define PG8_LDA(dst, b, h) do { _Pragma("unroll") for (int m = 0; m < 4; ++m) _Pragma("unroll") for (int k = 0; k < 2; ++k) dst[m][k] = *(const PG8_LAS bf16x8*)(lds + PG8_SA(b, h) + aoff + m * 2048 + k * 1024); } while (0)
#define PG8_LDB(dst, b, h) do { _Pragma("unroll") for (int n = 0; n < 2; ++n) _Pragma("unroll") for (int k = 0; k < 2; ++k) dst[n][k] = *(const PG8_LAS bf16x8*)(lds + PG8_SB(b, h) + boff + n * 2048 + k * 1024); } while (0)
#define PG8_MMA(ai, bj, At, Bt) do { __builtin_amdgcn_s_setprio(1); _Pragma("unroll") for (int m = 0; m < 4; ++m) _Pragma("unroll") for (int n = 0; n < 2; ++n) _Pragma("unroll") for (int k = 0; k < 2; ++k) \
        acc[ai][bj][m][n] = __builtin_amdgcn_mfma_f32_16x16x32_bf16(Bt[n][k], At[m][k], acc[ai][bj][m][n], 0, 0, 0); __builtin_amdgcn_s_setprio(0); } while (0)
#define PG8_WAIT_V(n) asm volatile("s_waitcnt vmcnt(" #n ")" ::: "memory")
#define PG8_WAIT_L(n) asm volatile("s_waitcnt lgkmcnt(" #n ")" ::: "memory")
#define PG8_BAR __builtin_amdgcn_s_barrier()
#define PG8_SCHED __builtin_amdgcn_sched_barrier(0)
    Unit cur, nxt; int ui = 0;
    if (!S.next(0, cur)) return;
    f32x4 acc[2][2][4][2];
#pragma unroll
    for (int a = 0; a < 2; ++a)
#pragma unroll
        for (int b = 0; b < 2; ++b)
#pragma unroll
            for (int m = 0; m < 4; ++m)
#pragma unroll
                for (int n = 0; n < 2; ++n) acc[a][b][m][n] = (f32x4){0.f, 0.f, 0.f, 0.f};
    bf16x8 At[4][2], B0[2][2], B1[2][2];
    const char* cA = (const char*)g.A + (size_t)cur.pm * tstep; const char* cB = (const char*)g.Bt + (size_t)cur.pn * tstep;
    S.a_ready(cur);
    if constexpr (SP2) {
        PG8_STAGE(PG8_SB(0, 0), cB, voffB); PG8_STAGE(PG8_SB(0, 1), cB + hstep, voffB); PG8_STAGE(PG8_SA(0, 0), cA, voffA); PG8_STAGE(PG8_SA(0, 1), cA + hstep, voffA);
        if (wr == 1) PG8_BAR;
        PG8_WAIT_V(2); PG8_BAR;
        PG8_STAGE(PG8_SB(1, 0), cB + kstep, voffB); PG8_STAGE(PG8_SA(1, 0), cA + kstep, voffA); PG8_STAGE(PG8_SB(1, 1), cB + hstep + kstep, voffB);
        PG8_WAIT_V(6); PG8_BAR;
    } else {
        PG8_STAGE(PG8_SB(0, 0), cB, voffB); PG8_STAGE(PG8_SA(0, 0), cA, voffA); PG8_STAGE(PG8_SB(0, 1), cB + hstep, voffB); PG8_STAGE(PG8_SA(0, 1), cA + hstep, voffA);
        if (wr == 1) PG8_BAR;
        PG8_WAIT_V(4); PG8_BAR;
        PG8_STAGE(PG8_SB(1, 0), cB + kstep, voffB); PG8_STAGE(PG8_SA(1, 0), cA + kstep, voffA); PG8_STAGE(PG8_SB(1, 1), cB + hstep + kstep, voffB);
        PG8_WAIT_V(6); PG8_BAR;
    }
    for (;;) {
        const bool has_next = S.next(ui + 1, nxt);
        const char* nA = has_next ? (const char*)g.A + (size_t)nxt.pm * tstep : cA; const char* nB = has_next ? (const char*)g.Bt + (size_t)nxt.pn * tstep : cB;
        for (int t = 0; t < nt; t += 2) {
            const bool last = (t == nt - 2);
            const char* a1 = cA + (size_t)(t + 1) * kstep;
            const char* a2 = last ? nA : cA + (size_t)(t + 2) * kstep; const char* b2 = last ? nB : cB + (size_t)(t + 2) * kstep;
            const char* a3 = a2 + kstep; const char* b3 = b2 + kstep;
            if (last && has_next) S.a_ready(nxt);
            if constexpr (SP2) {
            PG8_LDB(B0, 0, 0); PG8_LDB(B1, 0, 1); PG8_SCHED; PG8_LDA(At, 0, 0); PG8_STAGE(PG8_SA(1, 1), a1 + hstep, voffA);
            PG8_WAIT_V(8); PG8_WAIT_L(0); PG8_BAR; PG8_MMA(0, 0, At, B0); PG8_MMA(0, 1, At, B1); PG8_BAR; PG8_SCHED;
            PG8_LDA(At, 0, 1); PG8_STAGE(PG8_SB(0, 0), b2, voffB); PG8_STAGE(PG8_SB(0, 1), b2 + hstep, voffB); PG8_STAGE(PG8_SA(0, 0), a2, voffA);
            PG8_WAIT_V(8); PG8_WAIT_L(0); PG8_BAR; PG8_MMA(1, 0, At, B0); PG8_MMA(1, 1, At, B1); PG8_BAR; PG8_SCHED;
            PG8_LDB(B0, 1, 0); PG8_LDB(B1, 1, 1); PG8_SCHED; PG8_LDA(At, 1, 0); PG8_STAGE(PG8_SA(0, 1), a2 + hstep, voffA);
            PG8_WAIT_V(8); PG8_WAIT_L(0); PG8_BAR; PG8_MMA(0, 0, At, B0); PG8_MMA(0, 1, At, B1); PG8_BAR; PG8_SCHED;
            PG8_LDA(At, 1, 1); PG8_STAGE(PG8_SB(1, 0), b3, voffB); PG8_STAGE(PG8_SB(1, 1), b3 + hstep, voffB); PG8_STAGE(PG8_SA(1, 0), a3, voffA);
            PG8_WAIT_V(8); PG8_WAIT_L(0); PG8_BAR; PG8_MMA(1, 0, At, B0); PG8_MMA(1, 1, At, B1); PG8_BAR; PG8_SCHED;
            } else {
            PG8_LDB(B0, 0, 0); PG8_SCHED; PG8_LDA(At, 0, 0); PG8_STAGE(PG8_SA(1, 1), a1 + hstep, voffA);
            PG8_WAIT_L(8); PG8_BAR; PG8_WAIT_L(0); PG8_MMA(0, 0, At, B0); PG8_BAR; PG8_SCHED;
            PG8_LDB(B1, 0, 1); PG8_STAGE(PG8_SB(0, 0), b2, voffB);
            PG8_BAR; PG8_WAIT_L(0); PG8_MMA(0, 1, At, B1); PG8_BAR;
            PG8_LDA(At, 0, 1); PG8_STAGE(PG8_SA(0, 0), a2, voffA);
            PG8_BAR; PG8_WAIT_L(0); PG8_MMA(1, 0, At, B0); PG8_BAR; PG8_SCHED;
            PG8_STAGE(PG8_SB(0, 1), b2 + hstep, voffB);
            PG8_WAIT_V(6); PG8_BAR; PG8_MMA(1, 1, At, B1); PG8_BAR;
            PG8_LDB(B0, 1, 0); PG8_SCHED; PG8_LDA(At, 1, 0); PG8_STAGE(PG8_SA(0, 1), a2 + hstep, voffA);
            PG8_WAIT_L(8); PG8_BAR; PG8_WAIT_L(0); PG8_MMA(0, 0, At, B0); PG8_BAR; PG8_SCHED;
            PG8_LDB(B1, 1, 1); PG8_STAGE(PG8_SB(1, 0), b3, voffB);
            PG8_BAR; PG8_WAIT_L(0); PG8_MMA(0, 1, At, B1); PG8_BAR;
            PG8_LDA(At, 1, 1); PG8_STAGE(PG8_SA(1, 0), a3, voffA);
            PG8_BAR; PG8_WAIT_L(0); PG8_MMA(1, 0, At, B0); PG8_BAR; PG8_SCHED;
            PG8_STAGE(PG8_SB(1, 1), b3 + hstep, voffB);
            PG8_WAIT_V(6); PG8_BAR; PG8_MMA(1, 1, At, B1); PG8_BAR;
            }
        }
        if constexpr (ALIGN_EPI) { if (wr == 0) PG8_BAR; }
        if constexpr (!Epi::AFTER_DRAIN) { E(acc, cur, wr, wc, fr, fq); S.done(cur); }
        if (!has_next) break;
#pragma unroll
        for (int a = 0; a < 2; ++a)
#pragma unroll
            for (int b = 0; b < 2; ++b)
#pragma unroll
                for (int m = 0; m < 4; ++m)
#pragma unroll
                    for (int n = 0; n < 2; ++n) acc[a][b][m][n] = (f32x4){0.f, 0.f, 0.f, 0.f};
        cur = nxt; cA = nA; cB = nB; ++ui;
        if constexpr (ALIGN_EPI) { if (wr == 1) PG8_BAR; }
    }
    PG8_WAIT_V(0);
    if constexpr (!ALIGN_EPI) { if (wr == 0) PG8_BAR; }
    PG8_BAR;
    if constexpr (Epi::AFTER_DRAIN) { E.fused(acc, cur, wr, wc, fr, fq, lds, wid, lane); S.done(cur); }
#undef PG8_SA
#undef PG8_SB
#undef PG8_STAGE
#undef PG8_LDA
#undef PG8_LDB
#undef PG8_MMA
#undef PG8_WAIT_V
#undef PG8_WAIT_L
#undef PG8_BAR
#undef PG8_SCHED
}
}

typedef unsigned short bf16;
typedef short bf16x8 __attribute__((ext_vector_type(8)));
typedef float f32x4 __attribute__((ext_vector_type(4)));
typedef float f32x16 __attribute__((ext_vector_type(16)));
typedef unsigned u32x4 __attribute__((ext_vector_type(4)));
typedef unsigned u32x2 __attribute__((ext_vector_type(2)));

constexpr int DM = 1024, SEQ = 8192, MP = 16384, MS = 512, MT = MP + MS;
constexpr float EPSN = 1e-6f;
constexpr float LOG2E = 1.4426950408889634f;
constexpr size_t O_Y = 0, O_HP = (size_t)MT * DM, O_CONVP = O_HP + 2048, O_KP = O_CONVP + 6144, O_VP = O_KP + 65536, O_HS = O_VP + 65536,
                 O_CONVS = O_HS + 131072, O_KS = O_CONVS + 393216, O_VS = O_KS + 4194304, O_END = O_VS + 4194304;
constexpr size_t MiB = 1u << 20;
constexpr size_t WS_SS = 0;
constexpr size_t WS_SUM = 1 * MiB;
constexpr size_t WS_W1 = 4 * MiB, WS_WOA = 8 * MiB, WS_WPG0 = 10 * MiB, WS_WPP0 = 12 * MiB, WS_WPP1 = 12 * MiB + 512 * 1024, WS_WINB = 13 * MiB,
                 WS_WOB = 18 * MiB, WS_WPG1 = 20 * MiB, WS_WR = 22 * MiB, WS_WI = 22 * MiB + 256 * 1024;
constexpr size_t WS_PB = 24 * MiB;
constexpr size_t WS_SA = 41 * MiB, WS_SB = 74 * MiB, WS_SC = 107 * MiB, WS_SD = 140 * MiB, WS_KV = 173 * MiB;
constexpr size_t WS_SE = 190 * MiB;
constexpr size_t WS_END = 223 * MiB;
constexpr int LDS_BYTES = 147456;

__device__ __forceinline__ unsigned pk2(float lo, float hi) {
    typedef float f32x2_t __attribute__((ext_vector_type(2))); typedef __bf16 bf16x2_t __attribute__((ext_vector_type(2)));
    f32x2_t v = {lo, hi}; bf16x2_t b = __builtin_convertvector(v, bf16x2_t); return __builtin_bit_cast(unsigned, b);
}
__device__ __forceinline__ float bf2f(unsigned short b) { return __uint_as_float((unsigned)b << 16); }
__device__ __forceinline__ float bflo(unsigned w) { return __uint_as_float(w << 16); }
__device__ __forceinline__ float bfhi(unsigned w) { return __uint_as_float(w & 0xffff0000u); }
__device__ __forceinline__ float sigmoidf_(float v) { return __builtin_amdgcn_rcpf(1.0f + __expf(-v)); }
__device__ __forceinline__ float siluf_(float v) { return v * sigmoidf_(v); }
__device__ __forceinline__ int crow(int r, int hi) { return (r & 3) + 8 * (r >> 2) + 4 * hi; }
#define LDS_WAIT() asm volatile("s_waitcnt lgkmcnt(0)" ::: "memory")

namespace pg8 {
struct SubsetOrder {
    int nN, nwg, Gs, c;
    __device__ bool next(int i, Unit& u) const { if (c < 0) return false; const int L = i * Gs + c; if (L >= nwg) return false; u.pm = L / nN; u.pn = L % nN; return true; }
    __device__ __forceinline__ void a_ready(const Unit&) const {}
    __device__ __forceinline__ void done(const Unit&) const {}
};
struct EpiInA {
    static constexpr bool PERM = true, AFTER_DRAIN = false;
    const float* ss; bf16_t* XBR; bf16_t* GS; float* conv_p; float* conv_s;
    __device__ __forceinline__ void operator()(const f32x4 (&acc)[2][2][4][2], const Unit& u, int wr, int wc, int fr, int fq) const {
        const int colt = u.pn * BM; const bool is_gate = colt >= 1024;
        bf16_t* base = is_gate ? GS : XBR; const int cb = (is_gate ? colt - 1024 : colt) + wc * 32 + 8 * fq;
        float rsv[2][4];
#pragma unroll
        for (int ai = 0; ai < 2; ++ai)
#pragma unroll
            for (int m = 0; m < 4; ++m) rsv[ai][m] = ss[u.pm * BM + ai * HALF + wr * 64 + m * 16 + fr];
#pragma unroll
        for (int ai = 0; ai < 2; ++ai)
#pragma unroll
            for (int m = 0; m < 4; ++m) {
                const int row = u.pm * BM + ai * HALF + wr * 64 + m * 16 + fr;
                const float rs = rsqrtf(rsv[ai][m] * (1.0f / 1024.0f) + EPSN);
                float* cdst = nullptr;
                if (!is_gate) {
                    if (row < MP) { const int t = row & (SEQ - 1); if (t >= SEQ - 3) cdst = conv_p + (size_t)((row >> 13) * 3 + (t - (SEQ - 3))) * 1024; }
                    else { const int s = row - MP, t = s & 3; if (t >= 1) cdst = conv_s + (size_t)((s >> 2) * 3 + (t - 1)) * 1024; }
                }
#pragma unroll
                for (int bj = 0; bj < 2; ++bj) {
                    f32x4 v0 = acc[ai][bj][m][0] * rs, v1 = acc[ai][bj][m][1] * rs; const int col = cb + bj * HALF;
                    if (cdst) { *(f32x4*)(cdst + col) = v0; *(f32x4*)(cdst + col + 4) = v1; }
                    if (is_gate) {
#pragma unroll
                        for (int e = 0; e < 4; ++e) { v0[e] = siluf_(v0[e]); v1[e] = siluf_(v1[e]); }
                    }
                    u32x4 w; w.x = pk2(v0[0], v0[1]); w.y = pk2(v0[2], v0[3]); w.z = pk2(v1[0], v1[1]); w.w = pk2(v1[2], v1[3]);
                    *(u32x4*)(base + (size_t)row * 1024 + col) = w;
                }
            }
    }
};
struct EpiInB {
    static constexpr bool PERM = true, AFTER_DRAIN = false;
    const float* ss; bf16_t* QB; bf16_t* KB; bf16_t* VB; bf16_t* GS; float* kp; float* vp; float* ks; float* vs;
    __device__ __forceinline__ void operator()(const f32x4 (&acc)[2][2][4][2], const Unit& u, int wr, int wc, int fr, int fq) const {
        const int pn = u.pn; const int kind = pn < 4 ? 0 : (pn == 4 ? 1 : (pn == 5 ? 2 : 3));
        bf16_t* base; int ld, cb;
        if (kind == 0) { base = QB; ld = 1024; cb = pn * BM; } else if (kind == 1) { base = KB; ld = 256; cb = 0; } else if (kind == 2) { base = VB; ld = 256; cb = 0; } else { base = GS; ld = 1024; cb = (pn - 6) * BM; }
        cb += wc * 32 + 8 * fq;
        float* op = kind == 1 ? kp : vp; float* os = kind == 1 ? ks : vs;
        float rsv[2][4];
#pragma unroll
        for (int ai = 0; ai < 2; ++ai)
#pragma unroll
            for (int m = 0; m < 4; ++m) rsv[ai][m] = ss[u.pm * BM + ai * HALF + wr * 64 + m * 16 + fr];
#pragma unroll
        for (int ai = 0; ai < 2; ++ai)
#pragma unroll
            for (int m = 0; m < 4; ++m) {
                const int row = u.pm * BM + ai * HALF + wr * 64 + m * 16 + fr;
                const float rs = rsqrtf(rsv[ai][m] * (1.0f / 1024.0f) + EPSN);
                float* cdst = nullptr;
                if (kind == 1 || kind == 2) {
                    if (row < MP) { const int t = row & (SEQ - 1); if (t >= SEQ - 128) cdst = op + (size_t)((row >> 13) * 128 + (t - (SEQ - 128))) * 256; }
                    else { const int s = row - MP; cdst = os + (size_t)((s >> 2) * 128 + 124 + (s & 3)) * 256; }
                }
#pragma unroll
                for (int bj = 0; bj < 2; ++bj) {
                    f32x4 v0 = acc[ai][bj][m][0] * rs, v1 = acc[ai][bj][m][1] * rs; const int col = cb + bj * HALF;
                    if (cdst) { *(f32x4*)(cdst + col) = v0; *(f32x4*)(cdst + col + 4) = v1; }
                    if (kind == 3) {
#pragma unroll
                        for (int e = 0; e < 4; ++e) { v0[e] = siluf_(v0[e]); v1[e] = siluf_(v1[e]); }
                    }
                    u32x4 w; w.x = pk2(v0[0], v0[1]); w.y = pk2(v0[2], v0[3]); w.z = pk2(v1[0], v1[1]); w.w = pk2(v1[2], v1[3]);
                    *(u32x4*)(base + (size_t)row * ld + col) = w;
                }
            }
    }
};
#define EP_LD16(base, eoff) (*(const u32x4*)((const char*)(base) + (size_t)(unsigned)((eoff) * 2u)))
#define EP_ST16(base, eoff, v) (*(u32x4*)((char*)(base) + (size_t)(unsigned)((eoff) * 2u)) = (v))
struct EpiRes {
    static constexpr bool PERM = true, AFTER_DRAIN = false;
    const bf16_t* res; bf16_t* HB; float* ssout;
    __device__ __forceinline__ void operator()(const f32x4 (&acc)[2][2][4][2], const Unit& u, int wr, int wc, int fr, int fq) const {
        const int col0 = u.pn * BM + wc * 32 + 8 * fq; const int rowb = u.pm * BM + wr * 64 + fr;
        const unsigned ob = (unsigned)rowb * 1024u + (unsigned)col0;
        u32x4 buf[4][2];
#define EPI_LD(i, s) do { const unsigned o_ = ob + (unsigned)((((i) >> 2) * HALF + ((i) & 3) * 16) * 1024); buf[s][0] = EP_LD16(res, o_); buf[s][1] = EP_LD16(res, o_ + HALF); } while (0)
        EPI_LD(0, 0); EPI_LD(1, 1); EPI_LD(2, 2);
#pragma unroll
        for (int i = 0; i < 8; ++i) {
            if (i < 5) EPI_LD(i + 3, (i + 3) & 3);
            const int ai = i >> 2, m = i & 3; const int row = rowb + ai * HALF + m * 16; const unsigned orow = ob + (unsigned)((ai * HALF + m * 16) * 1024);
            float sq = 0.f;
#pragma unroll
            for (int bj = 0; bj < 2; ++bj) { const u32x4 rw = buf[i & 3][bj];
                const f32x4 h0 = (f32x4){bflo(rw.x), bfhi(rw.x), bflo(rw.y), bfhi(rw.y)} + acc[ai][bj][m][0], h1 = (f32x4){bflo(rw.z), bfhi(rw.z), bflo(rw.w), bfhi(rw.w)} + acc[ai][bj][m][1];
                u32x4 w; w.x = pk2(h0[0], h0[1]); w.y = pk2(h0[2], h0[3]); w.z = pk2(h1[0], h1[1]); w.w = pk2(h1[2], h1[3]); EP_ST16(HB, orow + bj * HALF, w);
                sq += ((h0[0] * h0[0] + h0[1] * h0[1]) + (h0[2] * h0[2] + h0[3] * h0[3])) + ((h1[0] * h1[0] + h1[1] * h1[1]) + (h1[2] * h1[2] + h1[3] * h1[3])); }
            sq += __shfl_xor(sq, 16); sq += __shfl_xor(sq, 32);
            if (fq == 0) atomicAdd(ssout + row, sq);
        }
#undef EPI_LD
    }
};
struct EpiPP {
    static constexpr bool PERM = true, AFTER_DRAIN = false;
    bf16_t* PP;
    __device__ __forceinline__ void operator()(const f32x4 (&acc)[2][2][4][2], const Unit& u, int wr, int wc, int fr, int fq) const {
        const unsigned ob = (unsigned)(u.pm * BM + wr * 64 + fr) * 1024u + (unsigned)(u.pn * BM + wc * 32 + 8 * fq);
#pragma unroll
        for (int ai = 0; ai < 2; ++ai)
#pragma unroll
            for (int m = 0; m < 4; ++m) {
#pragma unroll
                for (int bj = 0; bj < 2; ++bj) { const f32x4 h0 = acc[ai][bj][m][0], h1 = acc[ai][bj][m][1];
                    u32x4 w; w.x = pk2(h0[0], h0[1]); w.y = pk2(h0[2], h0[3]); w.z = pk2(h1[0], h1[1]); w.w = pk2(h1[2], h1[3]); EP_ST16(PP, ob + (unsigned)((ai * HALF + m * 16) * 1024 + bj * HALF), w); }
            }
    }
};
struct EpiPle {
    static constexpr bool PERM = true, AFTER_DRAIN = false;
    const float* ssin; const bf16_t* Hin; const bf16_t* PP; bf16_t* HB; float* ssout;
    __device__ __forceinline__ void operator()(const f32x4 (&acc)[2][2][4][2], const Unit& u, int wr, int wc, int fr, int fq) const {
        const int col0 = u.pn * BM + wc * 32 + 8 * fq; const int rowb = u.pm * BM + wr * 64 + fr;
        const unsigned ob = (unsigned)rowb * 1024u + (unsigned)col0;
        u32x4 hb[2][2], pb[2][2]; float rsb[2];
#define EPI_LD(i, s) do { const unsigned o_ = ob + (unsigned)((((i) >> 2) * HALF + ((i) & 3) * 16) * 1024); hb[s][0] = EP_LD16(Hin, o_); hb[s][1] = EP_LD16(Hin, o_ + HALF); \
            pb[s][0] = EP_LD16(PP, o_); pb[s][1] = EP_LD16(PP, o_ + HALF); rsb[s] = ssin[rowb + ((i) >> 2) * HALF + ((i) & 3) * 16]; } while (0)
        EPI_LD(0, 0);
#pragma unroll
        for (int i = 0; i < 8; ++i) {
            if (i < 7) EPI_LD(i + 1, (i + 1) & 1);
            const int ai = i >> 2, m = i & 3; const int row = rowb + ai * HALF + m * 16; const unsigned orow = ob + (unsigned)((ai * HALF + m * 16) * 1024);
            const float rs = rsqrtf(rsb[i & 1] * (1.0f / 1024.0f) + EPSN);
            float sq = 0.f;
#pragma unroll
            for (int bj = 0; bj < 2; ++bj) { const u32x4 hw = hb[i & 1][bj], pw = pb[i & 1][bj];
                const f32x4 a0 = acc[ai][bj][m][0] * rs, a1 = acc[ai][bj][m][1] * rs;
                f32x4 h0 = {bflo(hw.x), bfhi(hw.x), bflo(hw.y), bfhi(hw.y)}, h1 = {bflo(hw.z), bfhi(hw.z), bflo(hw.w), bfhi(hw.w)};
                h0[0] += sigmoidf_(a0[0]) * bflo(pw.x); h0[1] += sigmoidf_(a0[1]) * bfhi(pw.x); h0[2] += sigmoidf_(a0[2]) * bflo(pw.y); h0[3] += sigmoidf_(a0[3]) * bfhi(pw.y);
                h1[0] += sigmoidf_(a1[0]) * bflo(pw.z); h1[1] += sigmoidf_(a1[1]) * bfhi(pw.z); h1[2] += sigmoidf_(a1[2]) * bflo(pw.w); h1[3] += sigmoidf_(a1[3]) * bfhi(pw.w);
                u32x4 w; w.x = pk2(h0[0], h0[1]); w.y = pk2(h0[2], h0[3]); w.z = pk2(h1[0], h1[1]); w.w = pk2(h1[2], h1[3]); EP_ST16(HB, orow + bj * HALF, w);
                sq += ((h0[0] * h0[0] + h0[1] * h0[1]) + (h0[2] * h0[2] + h0[3] * h0[3])) + ((h1[0] * h1[0] + h1[1] * h1[1]) + (h1[2] * h1[2] + h1[3] * h1[3])); }
            sq += __shfl_xor(sq, 16); sq += __shfl_xor(sq, 32);
            if (fq == 0) atomicAdd(ssout + row, sq);
        }
#undef EPI_LD
    }
};
}

struct Args { const float* in[25]; float* out; unsigned char* ws; int ph_lo, ph_hi; };
enum { I_XP = 0, I_XS, I_PP, I_PS, I_LRUH, I_CONVST, I_CK, I_CV, I_NORMG, I_FNORMG, I_PLENG, I_WPG, I_WPP, I_WINA, I_CONVW, I_CONVB, I_WR, I_BR, I_WI, I_BI, I_LAM, I_WOA, I_WINB, I_SINKS, I_WOB };

__device__ __forceinline__ float wave_sum(float v) {
#pragma unroll
    for (int o = 1; o < 64; o <<= 1) v += __shfl_xor(v, o);
    return v;
}

__device__ __forceinline__ void p0_transpose_item(const float* W, int K, int N, bf16* WT, const float* g, float* scr, int item, int lane) {
    const int nblk = N / 32, kb = item / nblk, nb = item % nblk, k0 = 64 * kb, n0 = 32 * nb;
    float wv[32];
#pragma unroll
    for (int i = 0; i < 32; ++i) wv[i] = W[(size_t)(k0 + 2 * i + (lane >> 5)) * N + n0 + (lane & 31)];
#pragma unroll
    for (int i = 0; i < 32; ++i) { const int kk = 2 * i + (lane >> 5); float v = wv[i]; if (g) v *= g[k0 + kk]; scr[kk * 33 + (lane & 31)] = v; }
    LDS_WAIT();
    const int c = lane & 7;
#pragma unroll
    for (int j = 0; j < 4; ++j) { const int n = (lane >> 3) + 8 * j; const float* s = scr + (8 * c) * 33 + n;
        u32x4 o; o.x = pk2(s[0 * 33], s[1 * 33]); o.y = pk2(s[2 * 33], s[3 * 33]); o.z = pk2(s[4 * 33], s[5 * 33]); o.w = pk2(s[6 * 33], s[7 * 33]);
        *(u32x4*)(WT + (size_t)(n0 + n) * K + k0 + 8 * c) = o; }
    LDS_WAIT();
}

__device__ __forceinline__ void p0_prologue(const Args& a, unsigned char* lds, int tid, int lane, int wave, int bx, int G) {
    unsigned char* ws = a.ws;
    float* scr = (float*)(lds + wave * 16384);
    const int gw = bx * 8 + wave, NGW = G * 8;
    constexpr int I0 = 1024, I1 = 512, I2 = 512, I3 = 128, I4 = 512, I5 = 128, I6 = 1280, I7 = 512, I8 = 64, I9 = 64;
    constexpr int NITEMS = I0 + I1 + I2 + I3 + I4 + I5 + I6 + I7 + I8 + I9;
    for (int it = gw; it < NITEMS; it += NGW) {
        int r = it;
        if (r < I0) { p0_transpose_item(a.in[I_WINA], 1024, 2048, (bf16*)(ws + WS_W1), a.in[I_NORMG], scr, r, lane); continue; } r -= I0;
        if (r < I1) { p0_transpose_item(a.in[I_WOA], 1024, 1024, (bf16*)(ws + WS_WOA), nullptr, scr, r, lane); continue; } r -= I1;
        if (r < I2) { p0_transpose_item(a.in[I_WPG], 1024, 1024, (bf16*)(ws + WS_WPG0), a.in[I_PLENG], scr, r, lane); continue; } r -= I2;
        if (r < I3) { p0_transpose_item(a.in[I_WPP], 256, 1024, (bf16*)(ws + WS_WPP0), nullptr, scr, r, lane); continue; } r -= I3;
        if (r < I4) { p0_transpose_item(a.in[I_WPG] + 1024 * 1024, 1024, 1024, (bf16*)(ws + WS_WPG1), a.in[I_PLENG] + 1024, scr, r, lane); continue; } r -= I4;
        if (r < I5) { p0_transpose_item(a.in[I_WPP] + 256 * 1024, 256, 1024, (bf16*)(ws + WS_WPP1), nullptr, scr, r, lane); continue; } r -= I5;
        if (r < I6) { p0_transpose_item(a.in[I_WINB], 1024, 2560, (bf16*)(ws + WS_WINB), a.in[I_NORMG] + 1024, scr, r, lane); continue; } r -= I6;
        if (r < I7) { p0_transpose_item(a.in[I_WOB], 1024, 1024, (bf16*)(ws + WS_WOB), nullptr, scr, r, lane); continue; } r -= I7;
        if (r < I8) { const int blk = r >> 3; p0_transpose_item(a.in[I_WR] + blk * 16384, 128, 128, (bf16*)(ws + WS_WR) + blk * 16384, nullptr, scr, r & 7, lane); continue; } r -= I8;
        { const int blk = r >> 3; p0_transpose_item(a.in[I_WI] + blk * 16384, 128, 128, (bf16*)(ws + WS_WI) + blk * 16384, nullptr, scr, r & 7, lane); }
    }
    float* SS = (float*)(ws + WS_SS); bf16* XA = (bf16*)(ws + WS_SA);
    for (int m0 = 2 * gw; m0 < MT; m0 += 2 * NGW) {
        f32x4 v[2][4]; float sv[2];
#pragma unroll
        for (int rr = 0; rr < 2; ++rr) { const int m = m0 + rr; const float* xrow = m < MP ? a.in[I_XP] + (size_t)m * 1024 : a.in[I_XS] + (size_t)(m - MP) * 1024; const f32x4* xr = (const f32x4*)xrow + lane;
#pragma unroll
            for (int j = 0; j < 4; ++j) v[rr][j] = xr[64 * j]; }
#pragma unroll
        for (int rr = 0; rr < 2; ++rr) { float s = 0.f;
#pragma unroll
            for (int j = 0; j < 4; ++j) s += (v[rr][j].x * v[rr][j].x + v[rr][j].y * v[rr][j].y) + (v[rr][j].z * v[rr][j].z + v[rr][j].w * v[rr][j].w);
            sv[rr] = wave_sum(s); }
#pragma unroll
        for (int rr = 0; rr < 2; ++rr) { const int m = m0 + rr; u32x2* o8 = (u32x2*)(XA + (size_t)m * 1024) + lane;
#pragma unroll
            for (int j = 0; j < 4; ++j) { u32x2 w; w.x = pk2(v[rr][j].x, v[rr][j].y); w.y = pk2(v[rr][j].z, v[rr][j].w); o8[64 * j] = w; }
            if (lane == 0) { SS[m] = sv[rr]; SS[MT + m] = 0.f; SS[2 * MT + m] = 0.f; SS[3 * MT + m] = 0.f; SS[4 * MT + m] = 0.f; } }
    }
    bf16* PB = (bf16*)(ws + WS_PB);
    const int gt = bx * 512 + tid, NT = G * 512;
    for (int e0 = gt; e0 < 2 * MT * 32; e0 += 2 * NT) {
        f32x4 v0[2], v1[2]; bool ok[2]; size_t dst[2];
#pragma unroll
        for (int k = 0; k < 2; ++k) { const int e = e0 + k * NT; ok[k] = e < 2 * MT * 32; const int ee = ok[k] ? e : e0;
            const int l = ee / (MT * 32), rem = ee % (MT * 32), row = rem >> 5, q = rem & 31;
            const float* src = row < MP ? a.in[I_PP] + ((size_t)l * MP + row) * 256 + q * 8 : a.in[I_PS] + ((size_t)l * MS + (row - MP)) * 256 + q * 8;
            v0[k] = *(const f32x4*)src; v1[k] = *(const f32x4*)(src + 4); dst[k] = ((size_t)l * MT + row) * 256 + q * 8; }
#pragma unroll
        for (int k = 0; k < 2; ++k) if (ok[k]) { u32x4 w; w.x = pk2(v0[k].x, v0[k].y); w.y = pk2(v0[k].z, v0[k].w); w.z = pk2(v1[k].x, v1[k].y); w.w = pk2(v1[k].z, v1[k].w); *(u32x4*)(PB + dst[k]) = w; }
    }
}

constexpr int L_AB = 0, L_XC = 65536, L_XCB = 98304, L_SEG = 115712, XCBS = 136;
struct LruP { const bf16* XBR; const bf16* GS; bf16* HG; const bf16* WRt; const bf16* WIt; const float* convw; const float* convb; const float* br; const float* bi; const float* lam;
              const float* lruh; const float* convst; float* SUM; float* hp; float* hs; };

struct LruConsts { float w0, w1, w2, w3, cbv, brv, biv, sp8; };
template <bool XC_BF>
__device__ __forceinline__ void lru_gates_r(const bf16* XCB, const float* XC, float (&avr)[16], float (&bvr)[16], const bf16x8 (&wrf)[8], const bf16x8 (&wif)[8], const float brv, const float biv, const float sp8, int rb, int cbk, int jl, int hi) {
    f32x16 aR = {}, aI = {};
#pragma unroll
    for (int ks = 0; ks < 8; ++ks) { const bf16x8 af = *(const bf16x8*)(XCB + (32 * rb + jl) * XCBS + 16 * ks + 8 * hi);
        aR = __builtin_amdgcn_mfma_f32_32x32x16_bf16(af, wrf[ks], aR, 0, 0, 0); aI = __builtin_amdgcn_mfma_f32_32x32x16_bf16(af, wif[ks], aI, 0, 0, 0); }
    typedef float f32x2 __attribute__((ext_vector_type(2)));
#pragma unroll
    for (int r = 0; r < 16; r += 2) {
        const int i = 32 * rb + crow(r, hi), j = 32 * cbk + jl; const f32x2 xc = XC_BF ? (f32x2){bf2f(XCB[i * XCBS + j]), bf2f(XCB[(i + 1) * XCBS + j])} : (f32x2){XC[i * 128 + j], XC[(i + 1) * 128 + j]};
        const f32x2 zr = ((f32x2){aR[r], aR[r + 1]} + brv) * -LOG2E, zi = ((f32x2){aI[r], aI[r + 1]} + biv) * -LOG2E;
        f32x2 ea, eb; ea.x = __builtin_amdgcn_exp2f(fminf(zr.x, 60.f)); ea.y = __builtin_amdgcn_exp2f(fminf(zr.y, 60.f)); eb.x = __builtin_amdgcn_exp2f(fminf(zi.x, 60.f)); eb.y = __builtin_amdgcn_exp2f(fminf(zi.y, 60.f));
        ea = ea + 1.0f; eb = eb + 1.0f; const f32x2 den = ea * eb; f32x2 inv; inv.x = __builtin_amdgcn_rcpf(den.x); inv.y = __builtin_amdgcn_rcpf(den.y);
        const f32x2 rr = eb * inv, ii = ea * inv, la = rr * -sp8, le = la * LOG2E; f32x2 av; av.x = __builtin_amdgcn_exp2f(le.x); av.y = __builtin_amdgcn_exp2f(le.y);
        const f32x2 x2 = la * 2.0f; const f32x2 ser = -x2 * (x2 * (x2 * (x2 * 0.041666668f + 0.16666667f) + 0.5f) + 1.0f), big = 1.0f - av * av;
        f32x2 om; om.x = x2.x > -0.05f ? ser.x : big.x; om.y = x2.y > -0.05f ? ser.y : big.y;
        f32x2 sq; sq.x = __builtin_amdgcn_sqrtf(om.x); sq.y = __builtin_amdgcn_sqrtf(om.y);
        const f32x2 bb = sq * (ii * xc);
        avr[r] = av.x; avr[r + 1] = av.y; bvr[r] = bb.x; bvr[r + 1] = bb.y; }
}
__device__ __forceinline__ void lru_gates(const bf16* XCB, const float* XC, float* A_, float* B_, const bf16x8 (&wrf)[8], const bf16x8 (&wif)[8], const float brv, const float biv, const float sp8, int rb, int cbk, int jl, int hi) {
    float avr[16], bvr[16]; lru_gates_r<false>(XCB, XC, avr, bvr, wrf, wif, brv, biv, sp8, rb, cbk, jl, hi);
#pragma unroll
    for (int r = 0; r < 16; ++r) { const int i = 32 * rb + crow(r, hi), j = 32 * cbk + jl; A_[i * 128 + j] = avr[r]; B_[i * 128 + j] = bvr[r]; }
}
__device__ __forceinline__ void lru_out(const float* B_, bf16* HG, const u32x4 (&gv)[2], size_t row0, int n, int tid) {
#pragma unroll
    for (int k = 0; k < 2; ++k) { const int e = tid + 512 * k, rw = e >> 4, q = e & 15; const f32x4 h0 = *(const f32x4*)(B_ + rw * 128 + q * 8), h1 = *(const f32x4*)(B_ + rw * 128 + q * 8 + 4);
        u32x4 w; w.x = pk2(h0.x * bflo(gv[k].x), h0.y * bfhi(gv[k].x)); w.y = pk2(h0.z * bflo(gv[k].y), h0.w * bfhi(gv[k].y));
        w.z = pk2(h1.x * bflo(gv[k].z), h1.y * bfhi(gv[k].z)); w.w = pk2(h1.z * bflo(gv[k].w), h1.w * bfhi(gv[k].w));
        *(u32x4*)(HG + (row0 + rw) * 1024 + n * 128 + q * 8) = w; }
}
#define LRU_SETUP() \
    float* A_ = (float*)(lds + L_AB); float* B_ = A_ + 64 * 128; float* XC = (float*)(lds + L_XC); bf16* XCB = (bf16*)(lds + L_XCB); float* SEGP = (float*)(lds + L_SEG); float* SEGH = SEGP + 512; \
    const int ch = tid & 127, seg = tid >> 7, c = n * 128 + ch; \
    const int cbk = wave & 3, rb = wave >> 2, jl = lane & 31, hi = lane >> 5, cgc = n * 128 + 32 * cbk + jl; \
    LruConsts K; K.w0 = P.convw[c]; K.w1 = P.convw[1024 + c]; K.w2 = P.convw[2048 + c]; K.w3 = P.convw[3072 + c]; K.cbv = P.convb[c]; \
    K.brv = P.br[cgc]; K.biv = P.bi[cgc]; K.sp8 = 8.0f * log1pf(__expf(-P.lam[cgc])); \
    bf16x8 wrf[8], wif[8]; \
    _Pragma("unroll") for (int ks = 0; ks < 8; ++ks) { const size_t o = ((size_t)(n * 128 + 32 * cbk + jl)) * 128 + 16 * ks + 8 * hi; wrf[ks] = *(const bf16x8*)(P.WRt + o); wif[ks] = *(const bf16x8*)(P.WIt + o); }

__device__ __forceinline__ void lru_prompt(const LruP& P, bf16* HL, bf16* PC, unsigned char* lds, int tid, int lane, int wave, int b, int cI, int n) {
    LRU_SETUP();
    float Hrun = 0.f, Prun = 1.f;
    unsigned short xr[19];
    const bf16* xcol = P.XBR + (size_t)b * SEQ * 1024 + c;
#define LOADX(scn) do { const int tb_ = cI * 512 + (scn) * 64 + seg * 16 - 3; _Pragma("unroll") for (int i_ = 0; i_ < 19; ++i_) { const int t_ = tb_ + i_; const unsigned short v_ = xcol[(size_t)(t_ < 0 ? 0 : t_) * 1024]; xr[i_] = t_ < 0 ? (unsigned short)0 : v_; } } while (0)
    LOADX(0);
    for (int sc = 0; sc < 8; ++sc) {
        const size_t row0 = (size_t)b * SEQ + cI * 512 + sc * 64;
#pragma unroll
        for (int i = 0; i < 16; ++i) { const int jj = seg * 16 + i;
            const float xc = (((K.cbv + bf2f(xr[i]) * K.w0) + bf2f(xr[i + 1]) * K.w1) + bf2f(xr[i + 2]) * K.w2) + bf2f(xr[i + 3]) * K.w3;
            XCB[jj * XCBS + ch] = (bf16)(pk2(xc, 0.f) & 0xffffu); }
        if (sc < 7) LOADX(sc + 1);
        __syncthreads();
        float av[16], bv[16];
        lru_gates_r<true>(XCB, XC, av, bv, wrf, wif, K.brv, K.biv, K.sp8, rb, cbk, jl, hi);
        float gP[4], gH[4], qP[4], qH[4];
#pragma unroll
        for (int g = 0; g < 4; ++g) { float Hh = bv[4 * g], Pp = av[4 * g];
#pragma unroll
            for (int k = 1; k < 4; ++k) { Hh = av[4 * g + k] * Hh + bv[4 * g + k]; Pp *= av[4 * g + k]; }
            gP[g] = Pp; gH[g] = Hh; }
#pragma unroll
        for (int g = 0; g < 4; ++g) { qP[g] = __shfl_xor(gP[g], 32); qH[g] = __shfl_xor(gH[g], 32); }
        { float bP = 1.f, bH = 0.f;
#pragma unroll
          for (int g = 0; g < 4; ++g) { const float P0 = hi ? qP[g] : gP[g], H0 = hi ? qH[g] : gH[g], P1 = hi ? gP[g] : qP[g], H1 = hi ? gH[g] : qH[g];
              bH = P0 * bH + H0; bP *= P0; bH = P1 * bH + H1; bP *= P1; }
          if (hi == 0) { SEGP[rb * 128 + 32 * cbk + jl] = bP; SEGH[rb * 128 + 32 * cbk + jl] = bH; } }
        __syncthreads();
        { const int j = 32 * cbk + jl; const float P0b = SEGP[j], H0b = SEGH[j], P1b = SEGP[128 + j], H1b = SEGH[128 + j];
          float cur = rb ? P0b * Hrun + H0b : Hrun, pc = rb ? Prun * P0b : Prun;
          Hrun = P1b * (P0b * Hrun + H0b) + H1b; Prun = Prun * P0b * P1b;
#pragma unroll
          for (int g = 0; g < 4; ++g) { const float preP = hi ? qP[g] : 1.f, preH = hi ? qH[g] : 0.f, postP = hi ? 1.f : qP[g], postH = hi ? 0.f : qH[g];
              cur = preP * cur + preH; pc *= preP;
#pragma unroll
              for (int k = 0; k < 4; ++k) { const int r = 4 * g + k; cur = av[r] * cur + bv[r]; pc *= av[r]; bv[r] = cur; av[r] = pc; }
              cur = postP * cur + postH; pc *= postP; }
#pragma unroll
          for (int r = 0; r < 16; ++r) { const int i = 32 * rb + crow(r, hi); B_[i * 128 + j] = bv[r]; A_[i * 128 + j] = av[r]; }
          if (cI == 15 && sc == 7 && rb == 1 && hi == 1) P.hp[b * 1024 + n * 128 + j] = bv[15]; }
        __syncthreads();
#pragma unroll
        for (int k = 0; k < 2; ++k) { const int e = tid + 512 * k, rw = e >> 4, q = e & 15; const size_t o = (row0 + rw) * 1024 + n * 128 + q * 8;
            const f32x4 h0 = *(const f32x4*)(B_ + rw * 128 + q * 8), h1 = *(const f32x4*)(B_ + rw * 128 + q * 8 + 4), p0 = *(const f32x4*)(A_ + rw * 128 + q * 8), p1 = *(const f32x4*)(A_ + rw * 128 + q * 8 + 4);
            u32x4 w; w.x = pk2(h0.x, h0.y); w.y = pk2(h0.z, h0.w); w.z = pk2(h1.x, h1.y); w.w = pk2(h1.z, h1.w); *(u32x4*)(HL + o) = w;
            u32x4 v; v.x = pk2(p0.x, p0.y); v.y = pk2(p0.z, p0.w); v.z = pk2(p1.x, p1.y); v.w = pk2(p1.z, p1.w); *(u32x4*)(PC + o) = v; }
    }
#undef LOADX
    if (rb == 0 && hi == 0) { float* sp = P.SUM + ((size_t)(b * 16 + cI) * 1024 + n * 128 + 32 * cbk + jl) * 2; sp[0] = Prun; sp[1] = Hrun; }
    __syncthreads();
}
__device__ __forceinline__ void lru_fix(const LruP& P, bf16* HL, const bf16* PC, unsigned char* lds, int tid, int b, int cI, int n) {
    float* CAR = (float*)(lds + L_SEG);
    if (tid < 128) { const int c = n * 128 + tid; typedef float f32x2c __attribute__((ext_vector_type(2))); f32x2c sv[15]; float Hc = 0.f;
#pragma unroll
        for (int c2 = 0; c2 < 15; ++c2) { const int cc = c2 < cI ? c2 : 0; sv[c2] = *(const f32x2c*)(P.SUM + ((size_t)(b * 16 + cc) * 1024 + c) * 2); }
#pragma unroll
        for (int c2 = 0; c2 < 15; ++c2) if (c2 < cI) Hc = sv[c2].x * Hc + sv[c2].y;
        CAR[tid] = Hc; }
    __syncthreads();
    const int q = tid & 15, r0 = tid >> 4;
    const f32x4 c0 = *(const f32x4*)(CAR + q * 8), c1 = *(const f32x4*)(CAR + q * 8 + 4);
    const size_t base = ((size_t)b * SEQ + cI * 512 + r0) * 1024 + n * 128 + q * 8;
#pragma unroll 1
    for (int it = 0; it < 16; it += 8) {
        u32x4 hv[8], pv[8], gv[8];
#pragma unroll
        for (int k = 0; k < 8; ++k) { const size_t o = base + (size_t)(it + k) * 32 * 1024; hv[k] = *(const u32x4*)(HL + o); pv[k] = *(const u32x4*)(PC + o); gv[k] = *(const u32x4*)(P.GS + o); }
#pragma unroll
        for (int k = 0; k < 8; ++k) { const size_t o = base + (size_t)(it + k) * 32 * 1024;
            f32x4 h0 = {bflo(hv[k].x), bfhi(hv[k].x), bflo(hv[k].y), bfhi(hv[k].y)}, h1 = {bflo(hv[k].z), bfhi(hv[k].z), bflo(hv[k].w), bfhi(hv[k].w)};
            const f32x4 p0 = {bflo(pv[k].x), bfhi(pv[k].x), bflo(pv[k].y), bfhi(pv[k].y)}, p1 = {bflo(pv[k].z), bfhi(pv[k].z), bflo(pv[k].w), bfhi(pv[k].w)};
            h0 = h0 + p0 * c0; h1 = h1 + p1 * c1;
            if (cI == 15 && it + k == 15 && r0 == 31) { float* hp = P.hp + b * 1024 + n * 128 + q * 8; *(f32x4*)hp = h0; *(f32x4*)(hp + 4) = h1; }
            u32x4 w; w.x = pk2(h0.x * bflo(gv[k].x), h0.y * bfhi(gv[k].x)); w.y = pk2(h0.z * bflo(gv[k].y), h0.w * bfhi(gv[k].y));
            w.z = pk2(h1.x * bflo(gv[k].z), h1.y * bfhi(gv[k].z)); w.w = pk2(h1.z * bflo(gv[k].w), h1.w * bfhi(gv[k].w));
            *(u32x4*)(HL + o) = w; }
    }
    __syncthreads();
}

__device__ __forceinline__ void lru_sample(const LruP& P, unsigned char* lds, int tid, int lane, int wave, int n, int su) {
    LRU_SETUP();
    float* XS = (float*)(lds + L_AB);
    const size_t row0 = (size_t)MP + su * 64;
    u32x4 gv[2];
#pragma unroll
    for (int k = 0; k < 2; ++k) { const int e = tid + 512 * k, rw = e >> 4, q = e & 15; gv[k] = *(const u32x4*)(P.GS + (row0 + rw) * 1024 + n * 128 + q * 8); }
    for (int e = tid; e < 112 * 16; e += 512) { const int xr = e >> 4, q = e & 15, sq = xr / 7, k = xr - sq * 7, bs = su * 16 + sq; f32x4 f0, f1;
        if (k < 3) { const float* s = P.convst + ((size_t)bs * 3 + k) * 1024 + n * 128 + q * 8; f0 = *(const f32x4*)s; f1 = *(const f32x4*)(s + 4); }
        else { const u32x4 v = *(const u32x4*)(P.XBR + ((size_t)MP + bs * 4 + (k - 3)) * 1024 + n * 128 + q * 8); f0 = (f32x4){bflo(v.x), bfhi(v.x), bflo(v.y), bfhi(v.y)}; f1 = (f32x4){bflo(v.z), bfhi(v.z), bflo(v.w), bfhi(v.w)}; }
        *(f32x4*)(XS + xr * 128 + q * 8) = f0; *(f32x4*)(XS + xr * 128 + q * 8 + 4) = f1; }
    float h0v[4];
#pragma unroll
    for (int sq = 0; sq < 4; ++sq) h0v[sq] = P.lruh[(size_t)(su * 16 + seg * 4 + sq) * 1024 + c];
    __syncthreads();
#pragma unroll 4
    for (int i = 0; i < 16; ++i) { const int jj = seg * 16 + i; const int xb = (jj >> 2) * 7 + (jj & 3);
        const float xc = (((K.cbv + XS[xb * 128 + ch] * K.w0) + XS[(xb + 1) * 128 + ch] * K.w1) + XS[(xb + 2) * 128 + ch] * K.w2) + XS[(xb + 3) * 128 + ch] * K.w3;
        XC[jj * 128 + ch] = xc; XCB[jj * XCBS + ch] = (bf16)(pk2(xc, 0.f) & 0xffffu); }
    __syncthreads();
    lru_gates(XCB, XC, A_, B_, wrf, wif, K.brv, K.biv, K.sp8, rb, cbk, jl, hi);
    __syncthreads();
#pragma unroll
    for (int sq = 0; sq < 4; ++sq) { float h = h0v[sq];
#pragma unroll
        for (int t = 0; t < 4; ++t) { const int jj = (seg * 4 + sq) * 4 + t; h = A_[jj * 128 + ch] * h + B_[jj * 128 + ch]; B_[jj * 128 + ch] = h; }
        P.hs[(size_t)(su * 16 + seg * 4 + sq) * 1024 + c] = h; }
    __syncthreads();
    lru_out(B_, P.HG, gv, row0, n, tid);
    __syncthreads();
}

constexpr int A_KT = 0, KTS = 72, A_VT = 36864, VTS = 260, A_WSF = 70144, A_STG = 72192, STGS = 68;
constexpr int VTS_S = 164, AS_SET = 44032, AS_VT = 23040, AS_WSF = 88064, AS_STG = 90112;
struct AttP { const bf16* QB; const bf16* KB; const bf16* VB; const bf16* GS; bf16* OG; const float* sinks; const float* ck; const float* cv; float* ks; float* vs; };
#define CFENCE() asm volatile("" ::: "memory")

template <bool SAMPLE, int VS>
__device__ __forceinline__ void attn_block(const AttP& P, const bf16* KT, const bf16* VT, float* wsf, float* stg, int lane, const bf16x8 (&qr)[4], int i0, int kpos0, int qd, float slope2, float sink2,
                                           size_t orow0, int hcol0) {
    const int jl = lane & 31, hi = lane >> 5;
    f32x16 S[5];
    const bf16* kp = KT + (i0 + jl) * KTS + 8 * hi;
#pragma unroll
    for (int kb = 0; kb < 5; ++kb) { S[kb] = (f32x16){};
#pragma unroll
        for (int d0 = 0; d0 < 4; ++d0) { const bf16x8 kf = *(const bf16x8*)(kp + kb * 32 * KTS + 16 * d0); S[kb] = __builtin_amdgcn_mfma_f32_32x32x16_bf16(kf, qr[d0], S[kb], 0, 0, 0); }
        CFENCE(); }
    float m = sink2; const float c1 = 0.125f * LOG2E;
    int dq = qd - 4 * hi, kq = kpos0 + 4 * hi; asm volatile("" : "+v"(dq), "+v"(kq));
#pragma unroll
    for (int kb = 0; kb < 5; ++kb)
#pragma unroll
        for (int r = 0; r < 16; ++r) { const int x = 32 * kb + (r & 3) + 8 * (r >> 2), dist = dq - x; const bool valid = ((unsigned)dist < 128u) && (kq + x >= 0);
            const float s = valid ? S[kb][r] * c1 - slope2 * (float)dist : -1e30f; S[kb][r] = s; m = fmaxf(m, s); }
    m = fmaxf(m, __shfl_xor(m, 32));
    float ls = 0.f;
#pragma unroll
    for (int kb = 0; kb < 5; ++kb)
#pragma unroll
        for (int r = 0; r < 16; ++r) { const float p = __builtin_amdgcn_exp2f(S[kb][r] - m); S[kb][r] = p; ls += p; }
    ls += __shfl_xor(ls, 32); ls += __builtin_amdgcn_exp2f(sink2 - m);
    if (hi == 0) wsf[jl] = ls;
    constexpr int NPC = SAMPLE ? 2 : 4;
    u32x4 gv[NPC]; unsigned oo[NPC];
#pragma unroll
    for (int k = 0; k < NPC; ++k) { const int pc = lane + 64 * k, jq = pc >> 3, c8 = pc & 7;
        oo[k] = (unsigned)(SAMPLE ? (orow0 + (jq & 3)) * 1024 + hcol0 + (jq >> 2) * 64 + c8 * 8 : (orow0 + jq) * 1024 + hcol0 + c8 * 8); gv[k] = *(const u32x4*)(P.GS + oo[k]); }
    f32x16 O[2]; O[0] = (f32x16){}; O[1] = (f32x16){};
    const bf16* vp0 = VT + jl * VS + i0 + 4 * hi;
#pragma unroll
    for (int kb = 0; kb < 5; ++kb) {
#pragma unroll
        for (int s2 = 0; s2 < 2; ++s2) {
            u32x4 pw; pw.x = pk2(S[kb][8 * s2 + 0], S[kb][8 * s2 + 1]); pw.y = pk2(S[kb][8 * s2 + 2], S[kb][8 * s2 + 3]); pw.z = pk2(S[kb][8 * s2 + 4], S[kb][8 * s2 + 5]); pw.w = pk2(S[kb][8 * s2 + 6], S[kb][8 * s2 + 7]);
            const bf16x8 pf = __builtin_bit_cast(bf16x8, pw);
#pragma unroll
            for (int db = 0; db < 2; ++db) { const bf16* vp = vp0 + 32 * db * VS + 32 * kb + 16 * s2;
                const u32x2 lo = *(const u32x2*)vp, hh = *(const u32x2*)(vp + 8); const u32x4 vw = {lo.x, lo.y, hh.x, hh.y};
                O[db] = __builtin_amdgcn_mfma_f32_32x32x16_bf16(pf, __builtin_bit_cast(bf16x8, vw), O[db], 0, 0, 0); }
        }
        CFENCE(); }
    LDS_WAIT();
    const float* wl = wsf + 4 * hi;
#pragma unroll
    for (int r = 0; r < 16; ++r) { const int jr = (r & 3) + 8 * (r >> 2); const float rl = __builtin_amdgcn_rcpf(wl[jr]);
        stg[(jr + 4 * hi) * STGS + jl] = O[0][r] * rl; stg[(jr + 4 * hi) * STGS + 32 + jl] = O[1][r] * rl; }
    LDS_WAIT();
#pragma unroll
    for (int k = 0; k < NPC; ++k) { const int pc = lane + 64 * k, jq = pc >> 3, c8 = pc & 7; const f32x4 h0 = *(const f32x4*)(stg + jq * STGS + c8 * 8), h1 = *(const f32x4*)(stg + jq * STGS + c8 * 8 + 4);
        u32x4 w; w.x = pk2(h0.x * bflo(gv[k].x), h0.y * bfhi(gv[k].x)); w.y = pk2(h0.z * bflo(gv[k].y), h0.w * bfhi(gv[k].y));
        w.z = pk2(h1.x * bflo(gv[k].z), h1.y * bfhi(gv[k].z)); w.w = pk2(h1.z * bflo(gv[k].w), h1.w * bfhi(gv[k].w));
        *(u32x4*)(P.OG + oo[k]) = w; }
    LDS_WAIT();
}

__device__ __forceinline__ void attn_phase(const AttP& P, unsigned char* lds, int tid, int lane, int wave, int bx, int G) {
    {
        bf16* KT = (bf16*)(lds + A_KT); bf16* VT = (bf16*)(lds + A_VT); float* wsf = (float*)(lds + A_WSF) + wave * 64; float* stg = (float*)(lds + A_STG) + wave * (32 * STGS);
        u32x4 kreg[4], vreg[4];
#define ATT_PREF(uu) do { const int qb_ = (uu) & 63, kv_ = ((uu) >> 6) & 3, b_ = (uu) >> 8; _Pragma("unroll") for (int j_ = 0; j_ < 4; ++j_) { const int e_ = tid + 512 * j_, i_ = e_ >> 3, q_ = e_ & 7, kp_ = qb_ * 128 - 128 + i_; \
            const size_t o_ = ((size_t)b_ * SEQ + (kp_ < 0 ? 0 : kp_)) * 256 + kv_ * 64 + q_ * 8; kreg[j_] = *(const u32x4*)(P.KB + o_); vreg[j_] = *(const u32x4*)(P.VB + o_); \
            if (kp_ < 0) { kreg[j_] = (u32x4){0u, 0u, 0u, 0u}; vreg[j_] = kreg[j_]; } } } while (0)
        const int vb = (G % 8 == 0) ? (bx & 7) * (G >> 3) + (bx >> 3) : bx;
        if (vb < 512) ATT_PREF(vb);
        for (int u = vb; u < 512; u += G) {
            const int qb = u & 63, kv = (u >> 6) & 3, b = u >> 8, q0 = qb * 128;
            const int h = kv * 4 + (wave >> 1); const float slope2 = exp2f(-0.5f * (float)(h + 1)) * LOG2E, sink2 = P.sinks[h] * LOG2E;
            const int jl = lane & 31, hi = lane >> 5; bf16x8 qr0[4], qr1[4];
            { const bf16* qp = P.QB + ((size_t)b * SEQ + q0 + 64 * (wave & 1) + jl) * 1024 + h * 64 + 8 * hi;
#pragma unroll
              for (int d0 = 0; d0 < 4; ++d0) { qr0[d0] = *(const bf16x8*)(qp + 16 * d0); qr1[d0] = *(const bf16x8*)(qp + 32 * 1024 + 16 * d0); } }
#pragma unroll
            for (int j = 0; j < 4; ++j) { const int e = tid + 512 * j, i = e >> 3, q = e & 7; *(u32x4*)(KT + i * KTS + q * 8) = kreg[j]; const u32x4 vv = vreg[j];
                bf16* vd = VT + (q * 8) * VTS + i;
                vd[0] = (bf16)(vv.x & 0xffffu); vd[VTS] = (bf16)(vv.x >> 16); vd[2 * VTS] = (bf16)(vv.y & 0xffffu); vd[3 * VTS] = (bf16)(vv.y >> 16);
                vd[4 * VTS] = (bf16)(vv.z & 0xffffu); vd[5 * VTS] = (bf16)(vv.z >> 16); vd[6 * VTS] = (bf16)(vv.w & 0xffffu); vd[7 * VTS] = (bf16)(vv.w >> 16); }
            __syncthreads();
            if (u + G < 512) ATT_PREF(u + G);
            { const int qoff = 64 * (wave & 1), qa = q0 + qoff; const size_t rowq = (size_t)b * SEQ + qa;
              attn_block<false, VTS>(P, KT, VT, wsf, stg, lane, qr0, qoff, qa - 128, 128 + jl, slope2, sink2, rowq, h * 64); }
            { const int qoff = 64 * (wave & 1) + 32, qa = q0 + qoff; const size_t rowq = (size_t)b * SEQ + qa;
              attn_block<false, VTS>(P, KT, VT, wsf, stg, lane, qr1, qoff, qa - 128, 128 + jl, slope2, sink2, rowq, h * 64); }
            __syncthreads();
        }
#undef ATT_PREF
    }
    for (int it = bx; it < 256; it += G) {
        const int jn = tid >> 8, rn = tid & 255, in_ = 128 + (rn >> 6), dn = rn & 63, usn = 2 * it + jn; const size_t on = ((size_t)MP + (usn >> 2) * 4 + (in_ - 128)) * 256 + (usn & 3) * 64 + dn;
        const bf16 knew = P.KB[on], vnew = P.VB[on];
        bf16x8 qs[4]; float slope2 = 0.f, sink2 = 0.f; int tq = 0; size_t rowq = 0; int kvs = 0;
        if (wave < 2) { const int us = 2 * it + wave, kv = us & 3, b = us >> 2, jl = lane & 31, hi = lane >> 5, j = jl & 15, hh = j >> 2, t = j & 3, h = kv * 4 + hh;
            slope2 = exp2f(-0.5f * (float)(h + 1)) * LOG2E; sink2 = P.sinks[h] * LOG2E; tq = t; rowq = (size_t)MP + b * 4; kvs = kv;
            const bf16* qp = P.QB + (rowq + t) * 1024 + h * 64 + 8 * hi;
#pragma unroll
            for (int d0 = 0; d0 < 4; ++d0) qs[d0] = *(const bf16x8*)(qp + 16 * d0); }
        { f32x4 kfv[8], vfv[8];
#pragma unroll
          for (int k = 0; k < 8; ++k) { const int e = tid + 512 * k, j = e >> 11, r = e & 2047, i = r >> 4, q4 = r & 15, us = 2 * it + j, kv = us & 3, b = us >> 2;
              const size_t o = (((size_t)b * 128 + i) * 4 + kv) * 64 + q4 * 4; kfv[k] = *(const f32x4*)(P.ck + o); vfv[k] = *(const f32x4*)(P.cv + o); }
#pragma unroll
          for (int k = 0; k < 8; ++k) { const int e = tid + 512 * k, j = e >> 11, r = e & 2047, i = r >> 4, q4 = r & 15, us = 2 * it + j, kv = us & 3, b = us >> 2;
              const f32x4 kf = kfv[k], vf = vfv[k];
              if (i >= 4) { const size_t oo = (((size_t)b * 128 + i - 4) * 4 + kv) * 64 + q4 * 4; *(f32x4*)(P.ks + oo) = kf; *(f32x4*)(P.vs + oo) = vf; }
              bf16* KTs = (bf16*)(lds + j * AS_SET); bf16* VTs = (bf16*)(lds + j * AS_SET + AS_VT);
              u32x2 kw; kw.x = pk2(kf.x, kf.y); kw.y = pk2(kf.z, kf.w); *(u32x2*)(KTs + i * KTS + q4 * 4) = kw;
              const unsigned v01 = pk2(vf.x, vf.y), v23 = pk2(vf.z, vf.w); bf16* vd = VTs + (q4 * 4) * VTS_S + i;
              vd[0] = (bf16)(v01 & 0xffffu); vd[VTS_S] = (bf16)(v01 >> 16); vd[2 * VTS_S] = (bf16)(v23 & 0xffffu); vd[3 * VTS_S] = (bf16)(v23 >> 16); } }
        { bf16* KTs = (bf16*)(lds + jn * AS_SET); bf16* VTs = (bf16*)(lds + jn * AS_SET + AS_VT); KTs[in_ * KTS + dn] = knew; VTs[dn * VTS_S + in_] = vnew; }
        for (int e = tid; e < 2 * 28 * 64; e += 512) { const int j = e / (28 * 64), r = e - j * 28 * 64, i = 132 + (r >> 6), d = r & 63;
            bf16* KTs = (bf16*)(lds + j * AS_SET); bf16* VTs = (bf16*)(lds + j * AS_SET + AS_VT); KTs[i * KTS + d] = 0; VTs[d * VTS_S + i] = 0; }
        __syncthreads();
        if (wave < 2) { const bf16* KTs = (const bf16*)(lds + wave * AS_SET); const bf16* VTs = (const bf16*)(lds + wave * AS_SET + AS_VT);
            float* wsf = (float*)(lds + AS_WSF) + wave * 64; float* stg = (float*)(lds + AS_STG) + wave * (32 * STGS);
            attn_block<true, VTS_S>(P, KTs, VTs, wsf, stg, lane, qs, 0, 0, 128 + tq, slope2, sink2, rowq, kvs * 256); }
        __syncthreads();
    }
}

__device__ __forceinline__ void final_norm(float* Y, const bf16* Hb, const float* ss, const float* g, int lane, int wave, int bx, int G) {
    const int gw = bx * 8 + wave, NGW = G * 8;
    f32x4 gv[4];
#pragma unroll
    for (int j = 0; j < 2; ++j) { gv[2 * j] = *(const f32x4*)(g + 512 * j + 8 * lane); gv[2 * j + 1] = *(const f32x4*)(g + 512 * j + 8 * lane + 4); }
    u32x4 cur[2], nxt[2]; float sc = 0.f, sn = 0.f;
    if (gw < MT) { cur[0] = *(const u32x4*)(Hb + (size_t)gw * 1024 + 8 * lane); cur[1] = *(const u32x4*)(Hb + (size_t)gw * 1024 + 512 + 8 * lane); sc = ss[gw]; }
    for (int m = gw; m < MT; m += NGW) {
        const int mn = m + NGW;
        if (mn < MT) { nxt[0] = *(const u32x4*)(Hb + (size_t)mn * 1024 + 8 * lane); nxt[1] = *(const u32x4*)(Hb + (size_t)mn * 1024 + 512 + 8 * lane); sn = ss[mn]; }
        const float rs = rsqrtf(sc * (1.0f / 1024.0f) + EPSN);
#pragma unroll
        for (int j = 0; j < 2; ++j) { const u32x4 w = cur[j]; float* yp = Y + (size_t)m * 1024 + 512 * j + 8 * lane;
            *(f32x4*)yp = (f32x4){bflo(w.x), bfhi(w.x), bflo(w.y), bfhi(w.y)} * rs * gv[2 * j]; *(f32x4*)(yp + 4) = (f32x4){bflo(w.z), bfhi(w.z), bflo(w.w), bfhi(w.w)} * rs * gv[2 * j + 1]; }
        cur[0] = nxt[0]; cur[1] = nxt[1]; sc = sn;
    }
}

template <int NC>
__device__ __forceinline__ void sg_stage(unsigned char* lds, const bf16* Bt, int K, int c0, int tid) {
    const int ks = K + 8, cpr = K >> 3;
    __syncthreads();
    for (int e = tid; e < 16 * NC * cpr; e += 512) { const int r = e / cpr, q = e - r * cpr; *(u32x4*)((bf16*)lds + r * ks + q * 8) = *(const u32x4*)(Bt + (size_t)(c0 + r) * K + q * 8); }
    __syncthreads();
}
template <int NC, int K>
__device__ __forceinline__ void sg_acc(f32x4 (&acc)[NC], const bf16* A, const unsigned char* lds, int r0, int lane) {
    const int fr = lane & 15, fq = lane >> 4; constexpr int ks = K + 8;
    const bf16* ap = A + (size_t)(r0 + fr) * K + 8 * fq; const bf16* bp = (const bf16*)lds + fr * ks + 8 * fq;
    bf16x8 af[K / 32];
#pragma unroll
    for (int t = 0; t < K / 32; ++t) af[t] = *(const bf16x8*)(ap + 32 * t);
#pragma unroll
    for (int t = 0; t < K / 32; ++t)
#pragma unroll
        for (int j = 0; j < NC; ++j) { const bf16x8 bfr = *(const bf16x8*)(bp + j * 16 * ks + 32 * t); acc[j] = __builtin_amdgcn_mfma_f32_16x16x32_bf16(bfr, af[t], acc[j], 0, 0, 0); }
}
__device__ __forceinline__ void st_bf4(bf16* p, f32x4 v) { u32x2 w; w.x = pk2(v[0], v[1]); w.y = pk2(v[2], v[3]); *(u32x2*)p = w; }
__device__ __forceinline__ f32x4 ld_bf4(const bf16* p) { const u32x2 w = *(const u32x2*)p; return (f32x4){bflo(w.x), bfhi(w.x), bflo(w.y), bfhi(w.y)}; }
__device__ __forceinline__ void ss_add(float* ssp, int row, f32x4 h, int fq) { float sq = (h[0] * h[0] + h[1] * h[1]) + (h[2] * h[2] + h[3] * h[3]); sq += __shfl_xor(sq, 16); sq += __shfl_xor(sq, 32); if (fq == 0) atomicAdd(ssp + row, sq); }
__device__ __forceinline__ void s_inA(unsigned char* lds, const bf16* XA, const bf16* Wt, const float* ss, bf16* XBR, bf16* GS, float* conv_s, int tid, int wave, int lane, int bx, int G) {
    const int fr = lane & 15, fq = lane >> 4;
    for (int p = bx; p < 256; p += G) { const int r0 = MP + 128 * (p & 3) + 16 * wave, c0 = 32 * (p >> 2), row = r0 + fr, s = row - MP, t = s & 3;
        sg_stage<2>(lds, Wt, 1024, c0, tid);
        f32x4 acc[2] = {}; sg_acc<2, 1024>(acc, XA, lds, r0, lane);
        const float rs = rsqrtf(ss[row] * (1.0f / 1024.0f) + EPSN);
#pragma unroll
        for (int j = 0; j < 2; ++j) { const int col = c0 + 16 * j + 4 * fq; f32x4 v = acc[j] * rs;
            if (col < 1024) { st_bf4(XBR + (size_t)row * 1024 + col, v); if (t >= 1) *(f32x4*)(conv_s + (size_t)((s >> 2) * 3 + (t - 1)) * 1024 + col) = v; }
            else { v[0] = siluf_(v[0]); v[1] = siluf_(v[1]); v[2] = siluf_(v[2]); v[3] = siluf_(v[3]); st_bf4(GS + (size_t)row * 1024 + col - 1024, v); } } }
}
__device__ __forceinline__ void s_res(unsigned char* lds, const bf16* A, const bf16* Wt, const bf16* res, bf16* HB, float* ssout, int tid, int wave, int lane, int bx, int G) {
    const int fr = lane & 15, fq = lane >> 4;
    for (int p = bx; p < 256; p += G) { const int r0 = MP + 128 * (p & 3) + 16 * wave, c0 = 16 * (p >> 2), row = r0 + fr, col = c0 + 4 * fq;
        const f32x4 rv = ld_bf4(res + (size_t)row * 1024 + col);
        sg_stage<1>(lds, Wt, 1024, c0, tid);
        f32x4 acc[1] = {}; sg_acc<1, 1024>(acc, A, lds, r0, lane);
        const f32x4 h = rv + acc[0]; st_bf4(HB + (size_t)row * 1024 + col, h); ss_add(ssout, row, h, fq); }
}
__device__ __forceinline__ void s_ple(unsigned char* lds, const bf16* PBl, const bf16* Wpp, const bf16* Hin, const bf16* Wpg, const float* ssin, bf16* HB, float* ssout, int tid, int wave, int lane, int bx, int G) {
    const int fr = lane & 15, fq = lane >> 4;
    for (int p = bx; p < 256; p += G) { const int r0 = MP + 128 * (p & 3) + 16 * wave, c0 = 16 * (p >> 2), row = r0 + fr, col = c0 + 4 * fq;
        f32x4 hv = ld_bf4(Hin + (size_t)row * 1024 + col); const float rs = rsqrtf(ssin[row] * (1.0f / 1024.0f) + EPSN);
        sg_stage<1>(lds, Wpp, 256, c0, tid); f32x4 ap[1] = {}; sg_acc<1, 256>(ap, PBl, lds, r0, lane);
        sg_stage<1>(lds, Wpg, 1024, c0, tid); f32x4 ag[1] = {}; sg_acc<1, 1024>(ag, Hin, lds, r0, lane);
#pragma unroll
        for (int e = 0; e < 4; ++e) hv[e] += sigmoidf_(ag[0][e] * rs) * ap[0][e];
        st_bf4(HB + (size_t)row * 1024 + col, hv); ss_add(ssout, row, hv, fq); }
}


#define LAS __attribute__((address_space(3)))
#define XB_TMO      128
#define XB_XCNT(j)  (256  + 64 * (j))
#define XB_XSUB(j)  (1280 + 64 * (j))
#define XB_XGEN(j)  (2304 + 64 * (j))
#define XB_TOP      3328
#define XB_TOPGEN   3392
#define XCD_BAR_WORDS 3456
#define XB_SPIN_CAP (1u << 18)

__device__ __forceinline__ unsigned xb_ld(unsigned* p)              { return __hip_atomic_load(p, __ATOMIC_RELAXED, __HIP_MEMORY_SCOPE_AGENT); }
__device__ __forceinline__ unsigned xb_add(unsigned* p, unsigned v) { return __hip_atomic_fetch_add(p, v, __ATOMIC_RELAXED, __HIP_MEMORY_SCOPE_AGENT); }
__device__ __forceinline__ unsigned xb_xcc_id() { return (unsigned)__builtin_amdgcn_s_getreg((3 << 11) | 20) & 0xFu; }
#define XB_SPIN(cond, bar) do { unsigned _sp = 0; while (cond) { __builtin_amdgcn_s_sleep(1); \
    if ((++_sp & 255u) == 0u) { if (xb_ld(&(bar)[XB_TMO])) break; if (_sp > XB_SPIN_CAP) { atomicAdd(&(bar)[XB_TMO], 1u); break; } } } } while (0)

struct XcdBarrier {
    unsigned* bar; unsigned x;
    volatile LAS unsigned* st;
};

__device__ __forceinline__ XcdBarrier xcd_barrier_post(unsigned* bar, volatile LAS unsigned* st) {
    XcdBarrier b; b.bar = bar; b.x = xb_xcc_id(); b.st = st;
    if (threadIdx.x == 0) (void)xb_add(&bar[XB_XCNT(b.x)], 1u);
    return b;
}
__device__ __forceinline__ void xcd_barrier_complete(unsigned* bar, unsigned x, unsigned& nloc, unsigned& nx) {
    const unsigned G = gridDim.x * gridDim.y * gridDim.z;
    unsigned sum, cnt, mine, sp = 0u;
    for (;;) {
        sum = 0u; cnt = 0u; mine = 0u;
#pragma unroll
        for (unsigned j = 0; j < 16; ++j) { const unsigned c = xb_ld(&bar[XB_XCNT(j)]); sum += c; cnt += (c > 0u) ? 1u : 0u; mine = (j == x) ? c : mine; }
        if (sum == G) break;
        __builtin_amdgcn_s_sleep(1);
        if ((++sp & 255u) == 0u) { if (xb_ld(&bar[XB_TMO])) break; if (sp > XB_SPIN_CAP) { atomicAdd(&bar[XB_TMO], 1u); break; } }
    }
    nloc = mine > 0u ? mine : 1u; nx = cnt > 0u ? cnt : 1u;
}

__device__ __forceinline__ void xcd_barrier(const XcdBarrier& b) {
    asm volatile("s_waitcnt vmcnt(0)" ::: "memory");
    __syncthreads();
    if (threadIdx.x == 0) {
        unsigned* bar = b.bar;
        __builtin_amdgcn_s_waitcnt(0);
        unsigned nloc = b.st[0], nx = b.st[1];
        if (nloc == 0u) { xcd_barrier_complete(bar, b.x, nloc, nx); b.st[0] = nloc; b.st[1] = nx; }
        const unsigned old = xb_add(&bar[XB_XSUB(b.x)], 1u);
        const unsigned gen = old / nloc;
        if (old + 1u == (gen + 1u) * nloc) {
            __builtin_amdgcn_fence(__ATOMIC_RELEASE, "agent");
            asm volatile("s_waitcnt vmcnt(0)" ::: "memory");
            const unsigned og = xb_add(&bar[XB_TOP], 1u);
            const unsigned tg = og / nx;
            if (og + 1u == (tg + 1u) * nx) xb_add(&bar[XB_TOPGEN], 1u);
            else XB_SPIN(xb_ld(&bar[XB_TOPGEN]) == tg, bar);
            __builtin_amdgcn_fence(__ATOMIC_ACQUIRE, "agent");
            xb_add(&bar[XB_XGEN(b.x)], 1u);
            asm volatile("s_waitcnt vmcnt(0)" ::: "memory");
        } else {
            XB_SPIN(xb_ld(&bar[XB_XGEN(b.x)]) == gen, bar);
            __builtin_amdgcn_fence(__ATOMIC_ACQUIRE, "agent");
            asm volatile("s_waitcnt vmcnt(0)" ::: "memory");
        }
    }
    __syncthreads();
}

#ifndef GSYNC_SEAM0
#define GSYNC_SEAM0 0
#endif
constexpr size_t WS_BAR = 2 * MiB, BAR_BYTES = 16384;
constexpr int MISC_OFF = LDS_BYTES - 128;
constexpr int NPH = 11;
__global__ void __launch_bounds__(512, 2) mk_fwd(Args a) {
    extern __shared__ __attribute__((aligned(16))) unsigned char lds[];
#define TIDS() int tid = threadIdx.x; asm volatile("" : "+v"(tid)); const int lane = tid & 63, wave = __builtin_amdgcn_readfirstlane(tid >> 6); (void)lane; (void)wave
    const int G = gridDim.x, bx = blockIdx.x;
    cg::grid_group grid = cg::this_grid();
    unsigned char* ws = a.ws;
    const int lo = a.ph_lo, hi = a.ph_hi;
#ifndef PH_MASK
#define PH_MASK 0x7ff
#endif
#define IN(k) (((PH_MASK >> (k)) & 1) && lo <= (k) && (k) < hi)
#ifndef REP_MASK
#define REP_MASK 0
#endif
#define REPLOOP(k) for (int rep = ((REP_MASK >> (k)) & 1) ? 0 : 1; rep < 2; ++rep)
#define SEAM(k) do { if (IN(k) && IN((k) + 1)) { if (GSYNC_SEAM0 && (k) == 0) grid.sync(); else xcd_barrier(bar); } } while (0)
    if (lo < 0) grid.sync();
    PG8_LAS unsigned char* glds = (PG8_LAS unsigned char*)lds;
    volatile LAS unsigned* MISC = (volatile LAS unsigned*)(glds + MISC_OFF);
    if (threadIdx.x < 32) MISC[threadIdx.x] = 0u;
    __syncthreads();
    XcdBarrier bar; bar.bar = (unsigned*)(ws + WS_BAR); bar.x = 0; bar.st = nullptr;
    if (hi - lo > 1) bar = xcd_barrier_post((unsigned*)(ws + WS_BAR), MISC);
    float* SS = (float*)(ws + WS_SS);
    bf16* SA = (bf16*)(ws + WS_SA); bf16* SB = (bf16*)(ws + WS_SB); bf16* SC = (bf16*)(ws + WS_SC); bf16* SD = (bf16*)(ws + WS_SD); bf16* SE = (bf16*)(ws + WS_SE); bf16* KBF = (bf16*)(ws + WS_KV); bf16* VBF = KBF + (size_t)MT * 256;
    bf16* PB = (bf16*)(ws + WS_PB);
    float* out = a.out; float* SSD = SS + 5 * MT; (void)SSD;

    if (IN(0)) { TIDS(); REPLOOP(0) p0_prologue(a, lds, tid, lane, wave, bx, G); }
    SEAM(0);
    if (IN(1)) REPLOOP(1) {
        { pg8::Gemm g{SA, (const bf16*)(ws + WS_W1), MP, 2048, 1024}; pg8::StaticOrder S; S.init(MP, 2048, G, bx);
          pg8::EpiInA E{SS, SB, SC, out + O_CONVP, out + O_CONVS};
          pg8::gemm_phase<pg8::EpiInA, pg8::StaticOrder, true, true>(glds, g, S, E); }
        { TIDS(); s_inA(lds, SA, (const bf16*)(ws + WS_W1), SS, SB, SC, out + O_CONVS, tid, wave, lane, bx, G); }
    }
    SEAM(1);
    LruP LP{SB, SC, SD, (const bf16*)(ws + WS_WR), (const bf16*)(ws + WS_WI), a.in[I_CONVW], a.in[I_CONVB], a.in[I_BR], a.in[I_BI], a.in[I_LAM], a.in[I_LRUH], a.in[I_CONVST],
            (float*)(ws + WS_SUM), out + O_HP, out + O_HS};
    if (IN(2)) {
        TIDS();
        REPLOOP(2) for (int u = bx; u < 256; u += G) { const int n = u & 7, cI = (u >> 3) & 15, b = u >> 7; lru_prompt(LP, SD, SE, lds, tid, lane, wave, b, cI, n); }
    }
    SEAM(2);
    if (IN(3)) {
        TIDS();
        REPLOOP(3) for (int u = bx; u < 320; u += G) {
            if (u < 256) { const int n = u & 7, cI = (u >> 3) & 15, b = u >> 7; lru_fix(LP, SD, SE, lds, tid, b, cI, n); }
            else { const int v = u - 256; lru_sample(LP, lds, tid, lane, wave, v & 7, v >> 3); }
        }
    }
    SEAM(3);
    if (IN(4)) REPLOOP(4) {
        { pg8::Gemm g{SD, (const bf16*)(ws + WS_WOA), MP, 1024, 1024}; pg8::StaticOrder S; S.init(MP, 1024, G, bx);
          pg8::EpiRes E{SA, SB, rep ? SS + MT : SSD};
          pg8::gemm_phase<pg8::EpiRes, pg8::StaticOrder, true, true>(glds, g, S, E); }
        { TIDS(); s_res(lds, SD, (const bf16*)(ws + WS_WOA), SA, SB, rep ? SS + MT : SSD, tid, wave, lane, bx, G); }
    }
    SEAM(4);
    if (IN(5)) REPLOOP(5) {
        { pg8::Gemm g{PB, (const bf16*)(ws + WS_WPP0), MP, 1024, 256}; pg8::StaticOrder S; S.init(MP, 1024, G, bx); pg8::EpiPP E{SC};
          pg8::gemm_phase<pg8::EpiPP, pg8::StaticOrder, true, true>(glds, g, S, E); }
        __syncthreads();
        { pg8::Gemm g{SB, (const bf16*)(ws + WS_WPG0), MP, 1024, 1024}; pg8::StaticOrder S; S.init(MP, 1024, G, bx); pg8::EpiPle E{SS + MT, SB, SC, SA, rep ? SS + 2 * MT : SSD};
          pg8::gemm_phase<pg8::EpiPle, pg8::StaticOrder, true, true>(glds, g, S, E); }
        { TIDS(); s_ple(lds, PB, (const bf16*)(ws + WS_WPP0), SB, (const bf16*)(ws + WS_WPG0), SS + MT, SA, rep ? SS + 2 * MT : SSD, tid, wave, lane, bx, G); }
    }
    SEAM(5);
    if (IN(6)) REPLOOP(6) {
        { pg8::Gemm g{SA, (const bf16*)(ws + WS_WINB), MT, 2560, 1024}; pg8::StaticOrder S; S.init(MT, 2560, G, bx);
          pg8::EpiInB E{SS + 2 * MT, SB, KBF, VBF, SC, out + O_KP, out + O_VP, out + O_KS, out + O_VS};
          pg8::gemm_phase<pg8::EpiInB, pg8::StaticOrder, true, true>(glds, g, S, E); }
        __syncthreads();
        { const int nbig = (MT / 256) * 10, first = nbig - (nbig / G) * G;
          pg8::Gemm g{PB + (size_t)MT * 256, (const bf16*)(ws + WS_WPP1), MP, 1024, 256}; pg8::SubsetOrder S{4, 256, G - first, bx >= first ? bx - first : -1}; pg8::EpiPP E{SE};
          pg8::gemm_phase<pg8::EpiPP, pg8::SubsetOrder, true, true>(glds, g, S, E); }
    }
    SEAM(6);
    if (IN(7)) {
        TIDS();
        AttP AP{SB, KBF, VBF, SC, SD, a.in[I_SINKS], a.in[I_CK], a.in[I_CV], out + O_KS, out + O_VS};
        REPLOOP(7) attn_phase(AP, lds, tid, lane, wave, bx, G);
    }
    SEAM(7);
    if (IN(8)) REPLOOP(8) {
        { pg8::Gemm g{SD, (const bf16*)(ws + WS_WOB), MP, 1024, 1024}; pg8::StaticOrder S; S.init(MP, 1024, G, bx);
          pg8::EpiRes E{SA, SB, rep ? SS + 3 * MT : SSD};
          pg8::gemm_phase<pg8::EpiRes, pg8::StaticOrder, true, true>(glds, g, S, E); }
        { TIDS(); s_res(lds, SD, (const bf16*)(ws + WS_WOB), SA, SB, rep ? SS + 3 * MT : SSD, tid, wave, lane, bx, G); }
    }
    SEAM(8);
    if (IN(9)) REPLOOP(9) {
        { pg8::Gemm g{SB, (const bf16*)(ws + WS_WPG1), MP, 1024, 1024}; pg8::StaticOrder S; S.init(MP, 1024, G, bx); pg8::EpiPle E{SS + 3 * MT, SB, SE, SA, rep ? SS + 4 * MT : SSD};
          pg8::gemm_phase<pg8::EpiPle, pg8::StaticOrder, true, true>(glds, g, S, E); }
        { TIDS(); s_ple(lds, PB + (size_t)MT * 256, (const bf16*)(ws + WS_WPP1), SB, (const bf16*)(ws + WS_WPG1), SS + 3 * MT, SA, rep ? SS + 4 * MT : SSD, tid, wave, lane, bx, G); }
    }
    SEAM(9);
    if (IN(10)) { TIDS(); REPLOOP(10) final_norm(out + O_Y, SA, SS + 4 * MT, a.in[I_FNORMG], lane, wave, bx, G); }
#undef IN
#undef SEAM
}

#ifndef MK_N_LAUNCHES
#define MK_N_LAUNCHES 1
#endif
extern "C" void kernel_launch(void* const* d_in, const int* in_sizes, int n_in, void* d_out, int out_size, void* d_ws, size_t ws_size, hipStream_t stream) {
    static int grid = 0;
    if (grid == 0) {
        if (n_in != 25 || (size_t)out_size != O_END || ws_size < WS_END) { fprintf(stderr, "kernel_launch: unexpected shapes (n_in %d, out %d, ws %zu)\n", n_in, out_size, ws_size); grid = -1; return; }
        int dev = 0, cus = 0, per_cu = 0;
        if (hipGetDevice(&dev) != hipSuccess || hipDeviceGetAttribute(&cus, hipDeviceAttributeMultiprocessorCount, dev) != hipSuccess) { grid = -1; return; }
        if (hipFuncSetAttribute((const void*)mk_fwd, hipFuncAttributeMaxDynamicSharedMemorySize, LDS_BYTES) != hipSuccess) { fprintf(stderr, "kernel_launch: hipFuncSetAttribute failed\n"); grid = -1; return; }
        if (hipOccupancyMaxActiveBlocksPerMultiprocessor(&per_cu, (const void*)mk_fwd, 512, LDS_BYTES) != hipSuccess || per_cu < 1) { fprintf(stderr, "kernel_launch: occupancy query says %d\n", per_cu); per_cu = 1; }
        (void)hipGetLastError();
        grid = cus * (per_cu > 1 ? 1 : per_cu);
    }
    if (grid < 0) return;
    Args a{};
    for (int i = 0; i < 25; ++i) a.in[i] = (const float*)d_in[i];
    a.out = (float*)d_out; a.ws = (unsigned char*)d_ws;
    if (MK_N_LAUNCHES == 1) {
        if (hipMemsetAsync((char*)d_ws + WS_BAR, 0, BAR_BYTES, stream) != hipSuccess) { fprintf(stderr, "kernel_launch: memset failed\n"); return; }
        a.ph_lo = 0; a.ph_hi = NPH;
        void* args[] = {&a};
        hipError_t e = hipLaunchCooperativeKernel((const void*)mk_fwd, dim3(grid), dim3(512), args, LDS_BYTES, stream);
        if (e != hipSuccess) fprintf(stderr, "cooperative launch failed: %s (grid %d)\n", hipGetErrorString(e), grid);
    } else {
        for (int p = 0; p < NPH; ++p) { a.ph_lo = p; a.ph_hi = p + 1; hipLaunchKernelGGL(mk_fwd, dim3(grid), dim3(512), LDS_BYTES, stream, a); }
    }
}
```
